# Optimizing an MI355X kernel written in HIP

```python
import jax, jax.numpy as jnp
from jax import lax
import numpy as np

D_MODEL = 2048
BATCH = 1
SEQ = 16384
DEPTH = 1

NORM_EPS = 1e-6
PLE_DIM = 256
N_BRANCH = 2

MLA_HEADS = 8
MLA_NOPE = 128
MLA_ROPE = 64
MLA_QK = MLA_NOPE + MLA_ROPE
MLA_V = 128
MLA_Q_LORA = 512
MLA_KV_LORA = 512
MLA_WIDTH = MLA_HEADS * MLA_V
ROPE_THETA = 10000.0
Q_BLOCK = 128

RWKV_HEAD = 64
RWKV_HEADS = 16
RWKV_WIDTH = RWKV_HEADS * RWKV_HEAD
RWKV_DECAY_LORA = 96
RWKV_AAA_LORA = 96
RWKV_GATE_LORA = 256
RWKV_LN_EPS = 64e-5

N_GROUPS = 8
EXPERTS_PER_GROUP = 8
N_EXPERTS = N_GROUPS * EXPERTS_PER_GROUP
TOP_K_IN_GROUP = 2
D_EXPERT = 512
EXPERT_BLOCK = 128

MLA_IN = MLA_Q_LORA + MLA_KV_LORA + MLA_ROPE
RWKV_IN = 3 * RWKV_WIDTH + RWKV_DECAY_LORA + RWKV_AAA_LORA + RWKV_GATE_LORA
GATE_IN = N_BRANCH * D_MODEL
IN_TOTAL = MLA_IN + RWKV_IN + GATE_IN
RWKV_SPLITS = (RWKV_WIDTH, 2 * RWKV_WIDTH, 3 * RWKV_WIDTH, 3 * RWKV_WIDTH + RWKV_DECAY_LORA, 3 * RWKV_WIDTH + RWKV_DECAY_LORA + RWKV_AAA_LORA)

kernel_name = "hybrid_mla_rwkv7_hmoe_block"


def rmsnorm(x, g):
    xf = x.astype(jnp.float32)
    y = xf * lax.rsqrt(jnp.mean(xf * xf, axis=-1, keepdims=True) + NORM_EPS)
    return (y * g.astype(jnp.float32)).astype(x.dtype)


def apply_rope(t, cos, sin):
    half = t.shape[-1] // 2
    tf = t.astype(jnp.float32)
    t1, t2 = tf[..., :half], tf[..., half:]
    return jnp.concatenate([t1 * cos - t2 * sin, t2 * cos + t1 * sin], axis=-1).astype(t.dtype)


def token_shift(z):
    return jnp.pad(z, ((0, 0), (1, 0), (0, 0)))[:, :-1]


def mla_attention(c_q, c_kv, k_rope, positions, g_q_a, w_q_b, g_kv_a, w_kv_b, g_q_head, g_k_head):
    B, S, _ = c_q.shape
    q = (rmsnorm(c_q, g_q_a) @ w_q_b).reshape(B, S, MLA_HEADS, MLA_QK)
    kv = (rmsnorm(c_kv, g_kv_a) @ w_kv_b).reshape(B, S, MLA_HEADS, MLA_NOPE + MLA_V)
    k_nope, v = kv[..., :MLA_NOPE], kv[..., MLA_NOPE:]
    k = jnp.concatenate([k_nope, jnp.broadcast_to(k_rope[:, :, None, :], (B, S, MLA_HEADS, MLA_ROPE))], axis=-1)
    q = rmsnorm(q, g_q_head)
    k = rmsnorm(k, g_k_head)
    inv_freq = 1.0 / (ROPE_THETA ** (jnp.arange(0, MLA_ROPE, 2, dtype=jnp.float32) / MLA_ROPE))
    ang = positions.astype(jnp.float32)[..., None] * inv_freq
    cos = jnp.cos(ang)[:, :, None, :]
    sin = jnp.sin(ang)[:, :, None, :]
    q = jnp.concatenate([q[..., :MLA_NOPE], apply_rope(q[..., MLA_NOPE:], cos, sin)], axis=-1)
    k = jnp.concatenate([k[..., :MLA_NOPE], apply_rope(k[..., MLA_NOPE:], cos, sin)], axis=-1)
    scale = MLA_QK ** -0.5
    n_qb = S // Q_BLOCK
    qb = q.reshape(B, n_qb, Q_BLOCK, MLA_HEADS, MLA_QK).transpose(1, 0, 2, 3, 4)
    q_pos = jnp.arange(S).reshape(n_qb, Q_BLOCK)
    k_pos = jnp.arange(S)

    def attend_block(args):
        qi, qp = args
        s = jnp.einsum('bqhd,bkhd->bhqk', qi, k).astype(jnp.float32) * scale
        s = jnp.where(k_pos[None, :] <= qp[:, None], s, -jnp.inf)
        pr = jax.nn.softmax(s, axis=-1).astype(v.dtype)
        return jnp.einsum('bhqk,bkhd->bqhd', pr, v)

    o = lax.map(attend_block, (qb, q_pos))
    return o.transpose(1, 0, 2, 3, 4).reshape(B, S, MLA_WIDTH)


def _wkv7_step(state, inp):
    r_t, w_t, k_t, v_t, a_t, b_t = inp
    sa = jnp.einsum('bhvk,bhk->bhv', state, a_t)
    state = state * w_t[:, :, None, :] + sa[..., None] * b_t[:, :, None, :] + v_t[..., None] * k_t[:, :, None, :]
    return state, jnp.einsum('bhvk,bhk->bhv', state, r_t)


def rwkv7_time_mix(z, mu, w0, w2, a0, a2, g2, k_k, k_a, r_k, ln_g, ln_b):
    B, S, _ = z.shape
    f32 = jnp.float32
    z = z + (token_shift(z) - z) * mu
    r, k, v, zw, za, zg = jnp.split(z, RWKV_SPLITS, axis=-1)
    w_log = -jax.nn.softplus(-(w0 + jnp.tanh(zw) @ w2).astype(f32)) - 0.5
    decay = jnp.exp(-jnp.exp(w_log))
    a = jax.nn.sigmoid((a0 + za @ a2).astype(f32))
    g = (jax.nn.sigmoid(zg) @ g2).astype(f32)

    def heads(t):
        return t.astype(f32).reshape(B, S, RWKV_HEADS, RWKV_HEAD)

    kk = heads(k * k_k)
    kk = kk * lax.rsqrt(jnp.sum(kk * kk, axis=-1, keepdims=True) + 1e-12)
    k_mod = heads(k.astype(f32) * (1.0 + (a - 1.0) * k_a.astype(f32)))
    a_h = heads(a)
    r_h, v_h, w_h = heads(r), heads(v), heads(decay)

    def tm(t):
        return jnp.moveaxis(t, 1, 0)

    xs = (tm(r_h), tm(w_h), tm(k_mod), tm(v_h), tm(-kk), tm(kk * a_h))
    state0 = jnp.zeros((B, RWKV_HEADS, RWKV_HEAD, RWKV_HEAD), f32)
    _, y = lax.scan(_wkv7_step, state0, xs)
    y = jnp.moveaxis(y, 0, 1)
    mean = jnp.mean(y, axis=-1, keepdims=True)
    var = jnp.mean(jnp.square(y - mean), axis=-1, keepdims=True)
    y = ((y - mean) * lax.rsqrt(var + RWKV_LN_EPS)).reshape(B, S, RWKV_WIDTH)
    y = y * ln_g.astype(f32) + ln_b.astype(f32)
    bonus = (jnp.sum(r_h * k_mod * r_k.astype(f32), axis=-1, keepdims=True) * v_h).reshape(B, S, RWKV_WIDTH)
    return ((y + bonus) * g).astype(z.dtype)


def hier_moe(h, w_grp, b_grp, w_exp, b_exp, we_gate, we_up, we_down):
    B, S, D = h.shape
    T = B * S
    hf = h.reshape(T, D)
    grp_prob = jax.nn.softmax((hf @ w_grp).astype(jnp.float32) + b_grp.astype(jnp.float32), axis=-1)
    p_grp, g_idx = lax.top_k(grp_prob, 1)
    exp_logits = ((hf @ w_exp).astype(jnp.float32) + b_exp.astype(jnp.float32)).reshape(T, N_GROUPS, EXPERTS_PER_GROUP)
    in_grp = exp_logits[jnp.arange(T), g_idx[:, 0]]
    p_in = jax.nn.softmax(in_grp, axis=-1)
    p_top, e_local = lax.top_k(p_in, TOP_K_IN_GROUP)
    weights = p_grp * p_top / jnp.sum(p_top, axis=-1, keepdims=True)
    expert_id = g_idx * EXPERTS_PER_GROUP + e_local

    A = T * TOP_K_IN_GROUP
    e_flat = expert_id.reshape(A)
    w_flat = weights.reshape(A).astype(h.dtype)
    tok_flat = jnp.repeat(jnp.arange(T, dtype=jnp.int32), TOP_K_IN_GROUP)
    order = jnp.argsort(e_flat)
    e_sorted = e_flat[order]
    counts = jnp.zeros((N_EXPERTS,), jnp.int32).at[e_flat].add(1)
    padded = (counts + EXPERT_BLOCK - 1) // EXPERT_BLOCK * EXPERT_BLOCK
    pad_end = jnp.cumsum(padded)
    pad_start = pad_end - padded
    start = jnp.cumsum(counts) - counts
    dest = pad_start[e_sorted] + (jnp.arange(A, dtype=jnp.int32) - start[e_sorted])
    n_blocks = -(-A // EXPERT_BLOCK) + N_EXPERTS
    P = n_blocks * EXPERT_BLOCK
    row_tok = jnp.full((P,), T, jnp.int32).at[dest].set(tok_flat[order])
    row_w = jnp.zeros((P,), h.dtype).at[dest].set(w_flat[order])
    block_exp = jnp.minimum(jnp.searchsorted(pad_end, jnp.arange(n_blocks) * EXPERT_BLOCK, side='right'), N_EXPERTS - 1)
    h_pad = jnp.concatenate([hf, jnp.zeros((1, D), hf.dtype)], axis=0)
    xr = h_pad[row_tok].reshape(n_blocks, EXPERT_BLOCK, D)

    def expert_block(args):
        xb, e = args
        return (jax.nn.silu(xb @ we_gate[e]) * (xb @ we_up[e])) @ we_down[e]

    yr = lax.map(expert_block, (xr, block_exp)).reshape(P, D)
    out = jax.ops.segment_sum(yr * row_w[:, None], row_tok, num_segments=T + 1)[:T]
    return out.reshape(B, S, D)


def setup_inputs(seed: int = 0) -> dict:
    key = jax.random.key(seed)
    ks = iter(jax.random.split(key, 40))
    f32 = jnp.float32
    L = DEPTH

    def nrm(shape, scale):
        return jax.random.normal(next(ks), shape, f32) * scale

    def gain(shape):
        return 1.0 + nrm(shape, 0.02)

    x = nrm((BATCH, SEQ, D_MODEL), 1.0)
    p = nrm((DEPTH, BATCH, SEQ, PLE_DIM), 1.0)
    positions = (jnp.arange(SEQ, dtype=jnp.int32)[None, :] + jax.random.randint(next(ks), (BATCH, 1), 0, 1024, jnp.int32)).astype(jnp.int32)
    return {
        "x": x,
        "p": p,
        "positions": positions,
        "g_mix": gain((L, D_MODEL)),
        "w_in": nrm((L, D_MODEL, IN_TOTAL), D_MODEL ** -0.5),
        "g_q_a": gain((L, MLA_Q_LORA)),
        "w_q_b": nrm((L, MLA_Q_LORA, MLA_HEADS * MLA_QK), MLA_Q_LORA ** -0.5),
        "g_kv_a": gain((L, MLA_KV_LORA)),
        "w_kv_b": nrm((L, MLA_KV_LORA, MLA_HEADS * (MLA_NOPE + MLA_V)), MLA_KV_LORA ** -0.5),
        "g_q_head": gain((L, MLA_QK)),
        "g_k_head": gain((L, MLA_QK)),
        "mu_rwkv": jax.random.uniform(next(ks), (L, RWKV_IN), f32, 0.1, 0.9),
        "w0": jnp.linspace(-6.5, -1.5, RWKV_WIDTH, dtype=f32)[None, :] + nrm((L, RWKV_WIDTH), 0.1),
        "w2": nrm((L, RWKV_DECAY_LORA, RWKV_WIDTH), 0.1),
        "a0": nrm((L, RWKV_WIDTH), 0.1),
        "a2": nrm((L, RWKV_AAA_LORA, RWKV_WIDTH), 0.1),
        "g2": nrm((L, RWKV_GATE_LORA, RWKV_WIDTH), RWKV_GATE_LORA ** -0.5),
        "k_k": 0.85 + nrm((L, RWKV_WIDTH), 0.05),
        "k_a": 1.0 + nrm((L, RWKV_WIDTH), 0.05),
        "r_k": nrm((L, RWKV_HEADS, RWKV_HEAD), 0.1),
        "ln_x_g": gain((L, RWKV_WIDTH)),
        "ln_x_b": nrm((L, RWKV_WIDTH), 0.02),
        "w_branch": nrm((L, N_BRANCH, MLA_WIDTH, D_MODEL), MLA_WIDTH ** -0.5),
        "w_out": nrm((L, D_MODEL, D_MODEL), D_MODEL ** -0.5),
        "g_ffn": gain((L, D_MODEL)),
        "w_grp": nrm((L, D_MODEL, N_GROUPS), D_MODEL ** -0.5),
        "b_grp": nrm((L, N_GROUPS), 0.01),
        "w_exp": nrm((L, D_MODEL, N_EXPERTS), D_MODEL ** -0.5),
        "b_exp": nrm((L, N_EXPERTS), 0.01),
        "we_gate": nrm((L, N_EXPERTS, D_MODEL, D_EXPERT), D_MODEL ** -0.5),
        "we_up": nrm((L, N_EXPERTS, D_MODEL, D_EXPERT), D_MODEL ** -0.5),
        "we_down": nrm((L, N_EXPERTS, D_EXPERT, D_MODEL), D_EXPERT ** -0.5),
        "g_ple": gain((L, D_MODEL)),
        "w_ple_gate": nrm((L, D_MODEL, D_MODEL), D_MODEL ** -0.5),
        "w_ple_proj": nrm((L, PLE_DIM, D_MODEL), PLE_DIM ** -0.5),
        "g_ple_post": gain((L, D_MODEL)),
    }


def reference(x, p, positions, g_mix, w_in, g_q_a, w_q_b, g_kv_a, w_kv_b, g_q_head, g_k_head,
              mu_rwkv, w0, w2, a0, a2, g2, k_k, k_a, r_k, ln_x_g, ln_x_b,
              w_branch, w_out, g_ffn, w_grp, b_grp, w_exp, b_exp, we_gate, we_up, we_down,
              g_ple, w_ple_gate, w_ple_proj, g_ple_post):
    B, S, _ = x.shape
    for i in range(DEPTH):
        h = rmsnorm(x, g_mix[i])
        proj = h @ w_in[i]
        mla_in = proj[..., :MLA_IN]
        rwkv_in = proj[..., MLA_IN:MLA_IN + RWKV_IN]
        gate_in = proj[..., MLA_IN + RWKV_IN:]
        o_a = mla_attention(mla_in[..., :MLA_Q_LORA],
                            mla_in[..., MLA_Q_LORA:MLA_Q_LORA + MLA_KV_LORA],
                            mla_in[..., MLA_Q_LORA + MLA_KV_LORA:],
                            positions, g_q_a[i], w_q_b[i], g_kv_a[i], w_kv_b[i], g_q_head[i], g_k_head[i])
        o_b = rwkv7_time_mix(rwkv_in, mu_rwkv[i], w0[i], w2[i], a0[i], a2[i], g2[i],
                             k_k[i], k_a[i], r_k[i], ln_x_g[i], ln_x_b[i])
        branches = jnp.stack([o_a, o_b], axis=2)
        u = jnp.einsum('bsnc,ncd->bsnd', branches, w_branch[i])
        gates = jax.nn.sigmoid(gate_in.reshape(B, S, N_BRANCH, D_MODEL))
        merged = jnp.sum(gates * u, axis=2)
        x = x + merged @ w_out[i]
        x = x + hier_moe(rmsnorm(x, g_ffn[i]), w_grp[i], b_grp[i], w_exp[i], b_exp[i],
                         we_gate[i], we_up[i], we_down[i])
        ple = rmsnorm(p[i] @ w_ple_proj[i], g_ple_post[i])
        x = x + jax.nn.sigmoid(rmsnorm(x, g_ple[i]) @ w_ple_gate[i]) * ple
    return x
```

```cpp
#include <hip/hip_runtime.h>
#include <cstdio>
#include <cstdint>
#include <cmath>

#ifndef MK_ONE_LAUNCH
#define MK_ONE_LAUNCH 1
#endif

#define GAS __attribute__((address_space(1)))
#define LAS __attribute__((address_space(3)))
typedef unsigned short bf16_t;
typedef short bf16x8 __attribute__((ext_vector_type(8)));
typedef short s16x4 __attribute__((ext_vector_type(4)));
typedef float f32x4 __attribute__((ext_vector_type(4)));
typedef float f32x2 __attribute__((ext_vector_type(2)));
typedef float f32x16 __attribute__((ext_vector_type(16)));
typedef unsigned u32x4 __attribute__((ext_vector_type(4)));
typedef unsigned u32x2 __attribute__((ext_vector_type(2)));
typedef GAS unsigned gu32;

constexpr int T = 16384, DM = 2048;
constexpr int QL = 512, KVL = 512, ROPE = 64, NOPE = 128, QKD = 192, VD = 128, NH = 8;
constexpr int MLA_IN = QL + KVL + ROPE;
constexpr int RW = 1024, RH = 16, RN = 64, DLORA = 96, ALORA = 96, GLORA = 256;
constexpr int RWKV_IN = 3 * RW + DLORA + ALORA + GLORA;
constexpr int GATE_IN = 2 * DM;
constexpr int IN_TOTAL = MLA_IN + RWKV_IN + GATE_IN;
constexpr int NG = 8, EPG = 8, NE = 64, DE = 512;
constexpr int PLE = 256;
constexpr float EPS = 1e-6f, LN_EPS = 64e-5f;
constexpr int MAXTILES = 192;
constexpr int NSLOT = MAXTILES * 256;
constexpr int NROUTE = 256;

constexpr size_t MiB = 1u << 20;
constexpr size_t WS_CTL = 0, CTL_ZERO_BYTES = 1 * MiB;
constexpr size_t WS_WIN = 1 * MiB;
constexpr size_t WS_WQB = 35 * MiB;
constexpr size_t WS_WKVB = 37 * MiB;
constexpr size_t WS_W2T = 39 * MiB;
constexpr size_t WS_A2T = WS_W2T + 256 * 1024;
constexpr size_t WS_G2T = WS_W2T + 512 * 1024;
constexpr size_t WS_WBR = 40 * MiB;
constexpr size_t WS_WOUT = 48 * MiB;
constexpr size_t WS_WRT = 56 * MiB;
constexpr size_t WS_WPG = 57 * MiB;
constexpr size_t WS_WPP = 65 * MiB;
constexpr size_t WS_HB = 66 * MiB;
constexpr size_t WS_PB = 130 * MiB;
constexpr size_t WS_SMALL = 138 * MiB;
constexpr size_t WS_TAB = 144 * MiB;
constexpr size_t WS_BIG = 148 * MiB;
constexpr size_t WS_PROJ = WS_BIG;
constexpr size_t WS_Q = WS_PROJ + 272 * MiB;
constexpr size_t WS_KV = WS_Q + 48 * MiB;
constexpr size_t WS_KR = WS_KV + 64 * MiB;
constexpr size_t WS_OA = WS_KR + 48 * MiB;
constexpr size_t WS_OB = WS_OA + 32 * MiB;
constexpr size_t WS_LW = WS_OB + 32 * MiB;
constexpr size_t WS_AA = WS_LW + 64 * MiB;
constexpr size_t WS_GG = WS_AA + 32 * MiB;
constexpr size_t WS_TW = WS_GG + 32 * MiB;
constexpr size_t WS_ZA = WS_TW + 4 * MiB;
constexpr size_t WS_SG = WS_ZA + 4 * MiB;
constexpr size_t WS_MERGED = WS_SG + 8 * MiB;
constexpr size_t WS_YR = WS_MERGED + 64 * MiB;
constexpr size_t WS_PT = WS_YR + 64 * MiB;
constexpr size_t WS_LL = WS_PT + 32 * MiB;
constexpr size_t WS_MIX_END = WS_LL + 32 * MiB;
constexpr size_t WS_WGU_A = WS_Q;
constexpr size_t WS_WGU_B = WS_LW;
constexpr int WGU_SPLIT = 40;
constexpr size_t WS_WD = WS_YR;
constexpr size_t WS_X1B = WS_BIG;
constexpr size_t WS_Y = WS_X1B + 64 * MiB;
constexpr size_t WS_LOGITS = WS_Y + 192 * MiB;
constexpr size_t WS_ACT = WS_OA;
constexpr size_t WS_PLE = WS_MERGED;
constexpr size_t WS_X2B = WS_HB;
static_assert(WS_WGU_A + 40 * 4 * MiB <= WS_OA && WS_WGU_B + 24 * 4 * MiB <= WS_GG && WS_WD + 128 * MiB <= 1036 * MiB && WS_LOGITS + 16 * MiB <= WS_Q && WS_ACT + 48 * MiB <= WS_LW, "moe overlay");
constexpr size_t WS_MOE_END = WS_WD + 128 * MiB;
constexpr size_t WS_END = (WS_MIX_END > WS_MOE_END ? WS_MIX_END : WS_MOE_END);
static_assert(WS_END <= 1000 * MiB, "workspace map");
constexpr size_t SM_RSTDQ = 0, SM_RSTDKV = 64 * 1024, SM_RSTDPLE = 128 * 1024;
constexpr size_t SM_RSTD2 = 768 * 1024;
constexpr size_t SM_TOKE = 192 * 1024;
constexpr size_t SM_TOKP = 320 * 1024;
constexpr size_t SM_TOKW = 448 * 1024;
constexpr size_t SM_ROWTOK = 576 * 1024;
constexpr size_t SM_END = 832 * 1024;
constexpr int CW_BAR = 4096;
constexpr int CW_CNT = 16384;

constexpr int RING_BYTES = 131072;
constexpr int MISC_OFF = RING_BYTES;
constexpr int TAB_OFF = RING_BYTES + 256;
constexpr int LDS_BYTES = 147456;
constexpr int NWAVES = 8;

#define RLX_AGENT __ATOMIC_RELAXED, __HIP_MEMORY_SCOPE_AGENT
#define LDS_WAIT() asm volatile("s_waitcnt lgkmcnt(0)" ::: "memory")
#define VM_WAIT() asm volatile("s_waitcnt vmcnt(0)" ::: "memory")
__device__ __forceinline__ unsigned f2bf(float f) { unsigned u = __builtin_bit_cast(unsigned, f); return (u + 0x7fffu + ((u >> 16) & 1u)) >> 16; }
__device__ __forceinline__ unsigned pk2(float lo, float hi) { return f2bf(lo) | (f2bf(hi) << 16); }
__device__ __forceinline__ float bf2f(unsigned short b) { return __builtin_bit_cast(float, (unsigned)b << 16); }
__device__ __forceinline__ float bflo(unsigned w) { return __builtin_bit_cast(float, w << 16); }
__device__ __forceinline__ float bfhi(unsigned w) { return __builtin_bit_cast(float, w & 0xffff0000u); }
__device__ __forceinline__ unsigned cvtpk(float lo, float hi) { unsigned r; asm volatile("v_cvt_pk_bf16_f32 %0, %1, %2" : "=v"(r) : "v"(lo), "v"(hi)); return r; }
__device__ __forceinline__ float wave_sum(float v) {
#pragma unroll
    for (int o = 1; o < 64; o <<= 1) v += __shfl_xor(v, o);
    return v;
}
__device__ __forceinline__ float sigmoidf_(float x) { return 1.f / (1.f + __expf(-x)); }

#define XB_TMO      128
#define XB_XCNT(j)  (256  + 64 * (j))
#define XB_XSUB(j)  (1280 + 64 * (j))
#define XB_XGEN(j)  (2304 + 64 * (j))
#define XB_TOP      3328
#define XB_TOPGEN   3392
#define XCD_BAR_WORDS 3456
#define XB_SPIN_CAP (1u << 18)
__device__ __forceinline__ unsigned xb_ld(unsigned* p)              { return __hip_atomic_load(p, __ATOMIC_RELAXED, __HIP_MEMORY_SCOPE_AGENT); }
__device__ __forceinline__ unsigned xb_add(unsigned* p, unsigned v) { return __hip_atomic_fetch_add(p, v, __ATOMIC_RELAXED, __HIP_MEMORY_SCOPE_AGENT); }
__device__ __forceinline__ unsigned xb_xcc_id() { return (unsigned)__builtin_amdgcn_s_getreg((3 << 11) | 20) & 0xFu; }
#define XB_SPIN(cond, bar) do { unsigned _sp = 0; while (cond) { __builtin_amdgcn_s_sleep(1); \
    if ((++_sp & 255u) == 0u) { if (xb_ld(&(bar)[XB_TMO])) break; if (_sp > XB_SPIN_CAP) { atomicAdd(&(bar)[XB_TMO], 1u); break; } } } } while (0)
struct XcdBarrier { unsigned* bar; unsigned x; volatile LAS unsigned* st; };
__device__ __forceinline__ XcdBarrier xcd_barrier_post(unsigned* bar, volatile LAS unsigned* st) {
    XcdBarrier b; b.bar = bar; b.x = xb_xcc_id(); b.st = st;
    if (threadIdx.x == 0) (void)xb_add(&bar[XB_XCNT(b.x)], 1u);
    return b;
}
__device__ __forceinline__ void xcd_barrier_complete(unsigned* bar, unsigned x, unsigned& nloc, unsigned& nx) {
    const unsigned G = gridDim.x * gridDim.y * gridDim.z;
    unsigned sum, cnt, mine, sp = 0u;
    for (;;) {
        sum = 0u; cnt = 0u; mine = 0u;
#pragma unroll
        for (unsigned j = 0; j < 16; ++j) { const unsigned c = xb_ld(&bar[XB_XCNT(j)]); sum += c; cnt += (c > 0u) ? 1u : 0u; mine = (j == x) ? c : mine; }
        if (sum == G) break;
        __builtin_amdgcn_s_sleep(1);
        if ((++sp & 255u) == 0u) { if (xb_ld(&bar[XB_TMO])) break; if (sp > XB_SPIN_CAP) { atomicAdd(&bar[XB_TMO], 1u); break; } }
    }
    nloc = mine > 0u ? mine : 1u; nx = cnt > 0u ? cnt : 1u;
}
__device__ __forceinline__ void xcd_barrier(const XcdBarrier& b) {
    asm volatile("s_waitcnt vmcnt(0)" ::: "memory");
    __syncthreads();
    if (threadIdx.x == 0) {
        unsigned* bar = b.bar;
        __builtin_amdgcn_s_waitcnt(0);
        unsigned nloc = b.st[0], nx = b.st[1];
        if (nloc == 0u) { xcd_barrier_complete(bar, b.x, nloc, nx); b.st[0] = nloc; b.st[1] = nx; }
        const unsigned old = xb_add(&bar[XB_XSUB(b.x)], 1u);
        const unsigned gen = old / nloc;
        if (old + 1u == (gen + 1u) * nloc) {
            __builtin_amdgcn_fence(__ATOMIC_RELEASE, "agent");
            asm volatile("s_waitcnt vmcnt(0)" ::: "memory");
            const unsigned og = xb_add(&bar[XB_TOP], 1u);
            const unsigned tg = og / nx;
            if (og + 1u == (tg + 1u) * nx) xb_add(&bar[XB_TOPGEN], 1u);
            else XB_SPIN(xb_ld(&bar[XB_TOPGEN]) == tg, bar);
            __builtin_amdgcn_fence(__ATOMIC_ACQUIRE, "agent");
            xb_add(&bar[XB_XGEN(b.x)], 1u);
            asm volatile("s_waitcnt vmcnt(0)" ::: "memory");
        } else {
            XB_SPIN(xb_ld(&bar[XB_XGEN(b.x)]) == gen, bar);
            __builtin_amdgcn_fence(__ATOMIC_ACQUIRE, "agent");
            asm volatile("s_waitcnt vmcnt(0)" ::: "memory");
        }
    }
    __syncthreads();
}

namespace pg8 {
constexpr int BM = 256, BK = 64, HALF = 128, HTB = HALF * BK * 2, NXCD = 8, WGM = 8;
__host__ __device__ __forceinline__ int lds_byte(int r, int c) { const int st = (r >> 4) * 2 + (c >> 5), rr = r & 15, cc = c & 31, ob = rr * 64 + cc * 2; return st * 1024 + (ob ^ (((ob >> 9) & 1) << 5)); }
__host__ __device__ __forceinline__ void stage_rc(int b, int& R, int& C) { const int st = b / 1024, sb = b % 1024, swz = sb ^ (((sb >> 9) & 1) << 5); R = (st >> 1) * 16 + swz / 64; C = (st & 1) * 32 + (swz % 64) / 2; }
__host__ __device__ __forceinline__ int perm32(int rho) { const int n = rho >> 4, i = rho & 15; return 8 * (i >> 2) + 4 * n + (i & 3); }
struct Unit { int pm, pn; };
struct Gemm { const bf16_t* A; const bf16_t* Bt; int lda, ldb, K; const int* rowtok; };

struct StaticOrder {
    int nM, nN, nwg, G, c;
    __device__ __forceinline__ void init(int M, int N, int G_, int c_) { nM = M / BM; nN = N / BM; nwg = nM * nN; G = G_; c = c_; }
    __device__ __forceinline__ bool next(int i, Unit& u) const {
        const long L = (long)i * G + c; if (L >= nwg) return false;
        int wgid = (int)L; { const int q = nwg / NXCD, r = nwg % NXCD, xcd = wgid % NXCD, off = wgid / NXCD; wgid = (xcd < r ? xcd * (q + 1) : r * (q + 1) + (xcd - r) * q) + off; }
        const int nig = WGM * nN, gid = wgid / nig, fm = gid * WGM, gsz = (nM - fm) < WGM ? (nM - fm) : WGM;
        u.pm = fm + ((wgid % nig) % gsz); u.pn = (wgid % nig) / gsz; return true;
    }
    __device__ __forceinline__ const char* bptr(const Gemm& g, const Unit& u, size_t tstepB) const { return (const char*)g.Bt + (size_t)u.pn * tstepB; }
};
struct ListOrder {
    const LAS int* tab; int n;
    const char* base_a; const char* base_b; int split_e, npn; size_t estride;
    __device__ __forceinline__ const char* bptr(const Gemm&, const Unit& u, size_t tstepB) const { const int e = u.pn / npn, l = u.pn % npn;
        return (e < split_e ? base_a + (size_t)e * estride : base_b + (size_t)(e - split_e) * estride) + (size_t)l * tstepB; }
    __device__ __forceinline__ bool next(int i, Unit& u) const { if (i >= n) return false; u.pm = tab[2 * i]; u.pn = tab[2 * i + 1]; return true; }
};

template <class Epi, class Sched, bool GATHER>
__device__ __forceinline__ void gemm_phase(LAS unsigned char* lds, const Gemm g, const Sched& S, const Epi& E) {
    int tid_ = threadIdx.x; asm volatile("" : "+v"(tid_));
    const int tid = tid_, wid = __builtin_amdgcn_readfirstlane(tid >> 6), lane = tid & 63, wr = wid >> 2, wc = wid & 3, fr = lane & 15, fq = lane >> 4;
    const int K = g.K, nt = K / BK;
    unsigned voffA[2], voffB[2]; int RA[2], CA[2];
#pragma unroll
    for (int i = 0; i < 2; ++i) { int R, C; stage_rc(tid * 16 + i * 8192, R, C); const int Rb = (R & ~31) + perm32(R & 31);
        RA[i] = R; CA[i] = C; voffA[i] = (unsigned)(R * g.lda + C) * 2u; voffB[i] = (unsigned)(Rb * g.ldb + C) * 2u; }
    const size_t kstep = (size_t)(BK * 2);
    const size_t hstepA = (size_t)HALF * g.lda * 2, hstepB = (size_t)HALF * g.ldb * 2;
    const size_t tstepA = 2 * hstepA, tstepB = 2 * hstepB;
    const unsigned ldsw = (unsigned)wid * 1024u;
    const int aoff = lds_byte(wr * 64 + fr, fq * 8), boff = lds_byte(wc * 32 + fr, fq * 8);
#define PG8_SA(b, h) (((b) * 2 + (h)) * HTB)
#define PG8_SB(b, h) ((4 + (b) * 2 + (h)) * HTB)
#define PG8_STAGE(bufoff, gbase, voff) do { _Pragma("unroll") for (int _i = 0; _i < 2; ++_i) \
        __builtin_amdgcn_global_load_lds((const unsigned*)((const char*)(gbase) + (voff)[_i]), (LAS unsigned*)(lds + (bufoff) + ldsw + _i * 8192), 16, 0, 0); } while (0)
#define PG8_LDA(dst, b, h) do { _Pragma("unroll") for (int m = 0; m < 4; ++m) _Pragma("unroll") for (int k = 0; k < 2; ++k) dst[m][k] = *(const LAS bf16x8*)(lds + PG8_SA(b, h) + aoff + m * 2048 + k * 1024); } while (0)
#define PG8_LDB(dst, b, h) do { _Pragma("unroll") for (int n = 0; n < 2; ++n) _Pragma("unroll") for (int k = 0; k < 2; ++k) dst[n][k] = *(const LAS bf16x8*)(lds + PG8_SB(b, h) + boff + n * 2048 + k * 1024); } while (0)
#define PG8_MMA(ai, bj, At, Bt) do { __builtin_amdgcn_s_setprio(1); _Pragma("unroll") for (int m = 0; m < 4; ++m) _Pragma("unroll") for (int n = 0; n < 2; ++n) _Pragma("unroll") for (int k = 0; k < 2; ++k) \
        acc[ai][bj][m][n] = __builtin_amdgcn_mfma_f32_16x16x32_bf16(Bt[n][k], At[m][k], acc[ai][bj][m][n], 0, 0, 0); __builtin_amdgcn_s_setprio(0); } while (0)
#define PG8_WAIT_V(n) asm volatile("s_waitcnt vmcnt(" #n ")" ::: "memory")
#define PG8_WAIT_L(n) asm volatile("s_waitcnt lgkmcnt(" #n ")" ::: "memory")
#define PG8_BAR __builtin_amdgcn_s_barrier()
#define PG8_SCHED __builtin_amdgcn_sched_barrier(0)
#define PG8_GOFF(dst, u) do { _Pragma("unroll") for (int _h = 0; _h < 2; ++_h) _Pragma("unroll") for (int _i = 0; _i < 2; ++_i) { \
        int _t = __hip_atomic_load(g.rowtok + (u).pm * BM + _h * HALF + RA[_i], RLX_AGENT); if ((unsigned)_t >= (unsigned)T) _t = 0; \
        dst[_h][_i] = (unsigned)(_t * g.lda + CA[_i]) * 2u; } } while (0)
#define PG8_STAGE_A(b, h, tileptr, koff, goff) do { if constexpr (GATHER) { PG8_STAGE(PG8_SA(b, h), (const char*)g.A + (koff), (goff)[h]); } \
        else { PG8_STAGE(PG8_SA(b, h), (tileptr) + (h) * hstepA + (koff), voffA); } } while (0)
    Unit cur, nxt; int ui = 0;
    if (!S.next(0, cur)) return;
    f32x4 acc[2][2][4][2];
#pragma unroll
    for (int a = 0; a < 2; ++a)
#pragma unroll
        for (int b = 0; b < 2; ++b)
#pragma unroll
            for (int m = 0; m < 4; ++m)
#pragma unroll
                for (int n = 0; n < 2; ++n) acc[a][b][m][n] = (f32x4){0.f, 0.f, 0.f, 0.f};
    bf16x8 At[4][2], B0[2][2], B1[2][2];
    unsigned goC[2][2] = {{0u, 0u}, {0u, 0u}}, goN[2][2] = {{0u, 0u}, {0u, 0u}};
    const char* cA = (const char*)g.A + (GATHER ? (size_t)0 : (size_t)cur.pm * tstepA); const char* cB = S.bptr(g, cur, tstepB);
    if constexpr (GATHER) { PG8_GOFF(goC, cur); }
    PG8_STAGE(PG8_SB(0, 0), cB, voffB); PG8_STAGE(PG8_SB(0, 1), cB + hstepB, voffB); PG8_STAGE_A(0, 0, cA, 0, goC); PG8_STAGE_A(0, 1, cA, 0, goC);
    if (wr == 1) PG8_BAR;
    PG8_WAIT_V(2); PG8_BAR;
    PG8_STAGE(PG8_SB(1, 0), cB + kstep, voffB); PG8_STAGE_A(1, 0, cA, kstep, goC); PG8_STAGE(PG8_SB(1, 1), cB + hstepB + kstep, voffB);
    PG8_WAIT_V(6); PG8_BAR;
    for (;;) {
        const bool has_next = S.next(ui + 1, nxt);
        const char* nA = (has_next && !GATHER) ? (const char*)g.A + (size_t)nxt.pm * tstepA : cA; const char* nB = has_next ? S.bptr(g, nxt, tstepB) : cB;
        if constexpr (GATHER) { if (has_next) { PG8_GOFF(goN, nxt); } else {
#pragma unroll
            for (int h = 0; h < 2; ++h)
#pragma unroll
                for (int i = 0; i < 2; ++i) goN[h][i] = goC[h][i]; } }
        for (int t = 0; t < nt; t += 2) {
            const bool last = (t == nt - 2);
            const size_t k1 = (size_t)(t + 1) * kstep, k2 = last ? (size_t)0 : (size_t)(t + 2) * kstep, k3 = k2 + kstep;
            const char* a2 = last ? nA : cA; const char* b2 = (last ? nB : cB) + k2; const char* b3 = b2 + kstep;
            unsigned go2[2][2];
#pragma unroll
            for (int h = 0; h < 2; ++h)
#pragma unroll
                for (int i = 0; i < 2; ++i) go2[h][i] = last ? goN[h][i] : goC[h][i];
            PG8_LDB(B0, 0, 0); PG8_LDB(B1, 0, 1); PG8_SCHED; PG8_LDA(At, 0, 0); PG8_STAGE_A(1, 1, cA, k1, goC);
            PG8_WAIT_V(8); PG8_WAIT_L(0); PG8_BAR; PG8_MMA(0, 0, At, B0); PG8_MMA(0, 1, At, B1); PG8_BAR; PG8_SCHED;
            PG8_LDA(At, 0, 1); PG8_STAGE(PG8_SB(0, 0), b2, voffB); PG8_STAGE(PG8_SB(0, 1), b2 + hstepB, voffB); PG8_STAGE_A(0, 0, a2, k2, go2);
            PG8_WAIT_V(8); PG8_WAIT_L(0); PG8_BAR; PG8_MMA(1, 0, At, B0); PG8_MMA(1, 1, At, B1); PG8_BAR; PG8_SCHED;
            PG8_LDB(B0, 1, 0); PG8_LDB(B1, 1, 1); PG8_SCHED; PG8_LDA(At, 1, 0); PG8_STAGE_A(0, 1, a2, k2, go2);
            PG8_WAIT_V(8); PG8_WAIT_L(0); PG8_BAR; PG8_MMA(0, 0, At, B0); PG8_MMA(0, 1, At, B1); PG8_BAR; PG8_SCHED;
            PG8_LDA(At, 1, 1); PG8_STAGE(PG8_SB(1, 0), b3, voffB); PG8_STAGE(PG8_SB(1, 1), b3 + hstepB, voffB); PG8_STAGE_A(1, 0, a2, k3, go2);
            PG8_WAIT_V(8); PG8_WAIT_L(0); PG8_BAR; PG8_MMA(1, 0, At, B0); PG8_MMA(1, 1, At, B1); PG8_BAR; PG8_SCHED;
        }
        if (wr == 0) PG8_BAR;
        E(acc, cur, wr, wc, fr, fq);
        if (!has_next) break;
#pragma unroll
        for (int a = 0; a < 2; ++a)
#pragma unroll
            for (int b = 0; b < 2; ++b)
#pragma unroll
                for (int m = 0; m < 4; ++m)
#pragma unroll
                    for (int n = 0; n < 2; ++n) acc[a][b][m][n] = (f32x4){0.f, 0.f, 0.f, 0.f};
        cur = nxt; cA = nA; cB = nB; ++ui;
#pragma unroll
        for (int h = 0; h < 2; ++h)
#pragma unroll
            for (int i = 0; i < 2; ++i) goC[h][i] = goN[h][i];
        if (wr == 1) PG8_BAR;
    }
    PG8_WAIT_V(0);
    PG8_BAR;
#undef PG8_SA
#undef PG8_SB
#undef PG8_STAGE
#undef PG8_LDA
#undef PG8_LDB
#undef PG8_MMA
#undef PG8_WAIT_V
#undef PG8_WAIT_L
#undef PG8_BAR
#undef PG8_SCHED
#undef PG8_GOFF
#undef PG8_STAGE_A
}

template <class F> __device__ __forceinline__ void epi_rows(const f32x4 (&acc)[2][2][4][2], const Unit& u, int wr, int wc, int fr, int fq, F&& f) {
#pragma unroll
    for (int ai = 0; ai < 2; ++ai)
#pragma unroll
        for (int m = 0; m < 4; ++m) { const int row = u.pm * BM + ai * HALF + wr * 64 + m * 16 + fr;
#pragma unroll
            for (int bj = 0; bj < 2; ++bj) { const int col = u.pn * BM + bj * HALF + wc * 32 + 8 * fq; f(row, col, acc[ai][bj][m][0], acc[ai][bj][m][1]); } }
}
__device__ __forceinline__ u32x4 pack8(f32x4 a, f32x4 b) { u32x4 w; w.x = cvtpk(a[0], a[1]); w.y = cvtpk(a[2], a[3]); w.z = cvtpk(b[0], b[1]); w.w = cvtpk(b[2], b[3]); return w; }
__device__ __forceinline__ void unpack8f(u32x4 w, float* f) { f[0] = bflo(w.x); f[1] = bfhi(w.x); f[2] = bflo(w.y); f[3] = bfhi(w.y); f[4] = bflo(w.z); f[5] = bfhi(w.z); f[6] = bflo(w.w); f[7] = bfhi(w.w); }
__device__ __forceinline__ void split8(f32x4 v0, f32x4 v1, float* a) { a[0] = v0[0]; a[1] = v0[1]; a[2] = v0[2]; a[3] = v0[3]; a[4] = v1[0]; a[5] = v1[1]; a[6] = v1[2]; a[7] = v1[3]; }
__device__ __forceinline__ u32x4 pack8a(const float* o) { u32x4 w; w.x = cvtpk(o[0], o[1]); w.y = cvtpk(o[2], o[3]); w.z = cvtpk(o[4], o[5]); w.w = cvtpk(o[6], o[7]); return w; }

struct EpiBf16 {
    bf16_t* O; int ldc; const float* rs;
    __device__ __forceinline__ void operator()(const f32x4 (&acc)[2][2][4][2], const Unit& u, int wr, int wc, int fr, int fq) const {
        epi_rows(acc, u, wr, wc, fr, fq, [&](int row, int col, f32x4 v0, f32x4 v1) { const float s = rs ? rs[row] : 1.f; *(u32x4*)(O + (size_t)row * ldc + col) = pack8(v0 * s, v1 * s); });
    }
};
struct EpiF32 {
    float* O; int ldc;
    __device__ __forceinline__ void operator()(const f32x4 (&acc)[2][2][4][2], const Unit& u, int wr, int wc, int fr, int fq) const {
        epi_rows(acc, u, wr, wc, fr, fq, [&](int row, int col, f32x4 v0, f32x4 v1) { float* p = O + (size_t)row * ldc + col; *(f32x4*)p = v0; *(f32x4*)(p + 4) = v1; });
    }
};
struct EpiLogW {
    float* O; const float* w0;
    __device__ __forceinline__ void operator()(const f32x4 (&acc)[2][2][4][2], const Unit& u, int wr, int wc, int fr, int fq) const {
        epi_rows(acc, u, wr, wc, fr, fq, [&](int row, int col, f32x4 v0, f32x4 v1) { float a[8], o[8]; split8(v0, v1, a);
#pragma unroll
            for (int j = 0; j < 8; ++j) { const float x = -(w0[col + j] + a[j]); const float sp = fmaxf(x, 0.f) + __logf(1.f + __expf(-fabsf(x))); o[j] = -__expf(-sp - 0.5f); }
            float* p = O + (size_t)row * RW + col; *(f32x4*)p = (f32x4){o[0], o[1], o[2], o[3]}; *(f32x4*)(p + 4) = (f32x4){o[4], o[5], o[6], o[7]}; });
    }
};
struct EpiSigBias {
    bf16_t* O; const float* b;
    __device__ __forceinline__ void operator()(const f32x4 (&acc)[2][2][4][2], const Unit& u, int wr, int wc, int fr, int fq) const {
        epi_rows(acc, u, wr, wc, fr, fq, [&](int row, int col, f32x4 v0, f32x4 v1) { float a[8], o[8]; split8(v0, v1, a);
#pragma unroll
            for (int j = 0; j < 8; ++j) o[j] = sigmoidf_(b[col + j] + a[j]);
            *(u32x4*)(O + (size_t)row * RW + col) = pack8a(o); });
    }
};
template <bool ACCUM> struct EpiMerge {
    bf16_t* O; const bf16_t* gate;
    __device__ __forceinline__ void operator()(const f32x4 (&acc)[2][2][4][2], const Unit& u, int wr, int wc, int fr, int fq) const {
        epi_rows(acc, u, wr, wc, fr, fq, [&](int row, int col, f32x4 v0, f32x4 v1) { float a[8], gv[8], pv[8], o[8]; split8(v0, v1, a);
            unpack8f(*(const u32x4*)(gate + (size_t)row * IN_TOTAL + col), gv);
            if (ACCUM) unpack8f(*(const u32x4*)(O + (size_t)row * DM + col), pv);
#pragma unroll
            for (int j = 0; j < 8; ++j) { float r = sigmoidf_(gv[j]) * a[j]; if (ACCUM) r += pv[j]; o[j] = r; }
            *(u32x4*)(O + (size_t)row * DM + col) = pack8a(o); });
    }
};
struct EpiResid {
    bf16_t* O; const float* X; float* ssq;
    __device__ __forceinline__ void operator()(const f32x4 (&acc)[2][2][4][2], const Unit& u, int wr, int wc, int fr, int fq) const {
        epi_rows(acc, u, wr, wc, fr, fq, [&](int row, int col, f32x4 v0, f32x4 v1) { const size_t off = (size_t)row * DM + col; const f32x4 x0 = __builtin_nontemporal_load((const f32x4*)(X + off)), x1 = __builtin_nontemporal_load((const f32x4*)(X + off + 4));
            const u32x4 w = pack8(x0 + v0, x1 + v1); *(u32x4*)(O + off) = w;
            float f[8]; unpack8f(w, f); float s = ((f[0] * f[0] + f[1] * f[1]) + (f[2] * f[2] + f[3] * f[3])) + ((f[4] * f[4] + f[5] * f[5]) + (f[6] * f[6] + f[7] * f[7]));
            s += __shfl_xor(s, 16); s += __shfl_xor(s, 32);
            if (fq == 0) (void)__hip_atomic_fetch_add(ssq + row, s, RLX_AGENT); });
    }
};
struct EpiBf16Ssq {
    bf16_t* O; int ldc; float* ssq;
    __device__ __forceinline__ void operator()(const f32x4 (&acc)[2][2][4][2], const Unit& u, int wr, int wc, int fr, int fq) const {
        epi_rows(acc, u, wr, wc, fr, fq, [&](int row, int col, f32x4 v0, f32x4 v1) { const u32x4 w = pack8(v0, v1); *(u32x4*)(O + (size_t)row * ldc + col) = w;
            float f[8]; unpack8f(w, f); float s = ((f[0] * f[0] + f[1] * f[1]) + (f[2] * f[2] + f[3] * f[3])) + ((f[4] * f[4] + f[5] * f[5]) + (f[6] * f[6] + f[7] * f[7]));
            s += __shfl_xor(s, 16); s += __shfl_xor(s, 32);
            if (fq == 0) (void)__hip_atomic_fetch_add(ssq + row, s, RLX_AGENT); });
    }
};
struct EpiF32Rs {
    float* O; int ldc; const float* ssq;
    __device__ __forceinline__ void operator()(const f32x4 (&acc)[2][2][4][2], const Unit& u, int wr, int wc, int fr, int fq) const {
        epi_rows(acc, u, wr, wc, fr, fq, [&](int row, int col, f32x4 v0, f32x4 v1) { const float rs = rsqrtf(ssq[row] * (1.f / DM) + EPS); float* p = O + (size_t)row * ldc + col; *(f32x4*)p = v0 * rs; *(f32x4*)(p + 4) = v1 * rs; });
    }
};
struct EpiSwiGLU {
    bf16_t* O; const int* rowtok; const float* ssq;
    __device__ __forceinline__ void operator()(const f32x4 (&acc)[2][2][4][2], const Unit& u, int wr, int wc, int fr, int fq) const {
#pragma unroll
        for (int ai = 0; ai < 2; ++ai)
#pragma unroll
            for (int m = 0; m < 4; ++m) { const int row = u.pm * BM + ai * HALF + wr * 64 + m * 16 + fr; const int col = (u.pn & 3) * 128 + wc * 32 + 8 * fq;
                int tk = __hip_atomic_load(rowtok + row, RLX_AGENT); if ((unsigned)tk >= (unsigned)T) tk = 0;
                const float rs = rsqrtf(ssq[tk] * (1.f / DM) + EPS);
                float gt[8], up[8], o[8]; split8(acc[ai][0][m][0], acc[ai][0][m][1], gt); split8(acc[ai][1][m][0], acc[ai][1][m][1], up);
#pragma unroll
                for (int j = 0; j < 8; ++j) { gt[j] *= rs; up[j] *= rs; }
#pragma unroll
                for (int j = 0; j < 8; ++j) o[j] = gt[j] * sigmoidf_(gt[j]) * up[j];
                *(u32x4*)(O + (size_t)row * DE + col) = pack8a(o); }
    }
};
struct EpiDown {
    bf16_t* O;
    __device__ __forceinline__ void operator()(const f32x4 (&acc)[2][2][4][2], const Unit& u, int wr, int wc, int fr, int fq) const {
#pragma unroll
        for (int ai = 0; ai < 2; ++ai)
#pragma unroll
            for (int m = 0; m < 4; ++m) { const int row = u.pm * BM + ai * HALF + wr * 64 + m * 16 + fr;
#pragma unroll
                for (int bj = 0; bj < 2; ++bj) { const int col = (u.pn & 7) * BM + bj * HALF + wc * 32 + 8 * fq;
                    *(u32x4*)(O + (size_t)row * DM + col) = pack8(acc[ai][bj][m][0], acc[ai][bj][m][1]); } }
    }
};
struct EpiPle {
    float* O; const bf16_t* X2; const bf16_t* P; const float* rstd; const float* rstd2; const float* gpost;
    __device__ __forceinline__ void operator()(const f32x4 (&acc)[2][2][4][2], const Unit& u, int wr, int wc, int fr, int fq) const {
        epi_rows(acc, u, wr, wc, fr, fq, [&](int row, int col, f32x4 v0, f32x4 v1) { const size_t off = (size_t)row * DM + col; float a[8], pv[8], xx[8], o[8]; split8(v0, v1, a);
            unpack8f(__builtin_nontemporal_load((const u32x4*)(P + off)), pv); unpack8f(__builtin_nontemporal_load((const u32x4*)(X2 + off)), xx); const float rs = rsqrtf(rstd[row] * (1.f / DM) + EPS), r2 = rstd2[row];
#pragma unroll
            for (int j = 0; j < 8; ++j) o[j] = xx[j] + sigmoidf_(a[j] * r2) * pv[j] * rs * gpost[col + j];
            __builtin_nontemporal_store((f32x4){o[0], o[1], o[2], o[3]}, (f32x4*)(O + off)); __builtin_nontemporal_store((f32x4){o[4], o[5], o[6], o[7]}, (f32x4*)(O + off + 4)); });
    }
};
}

namespace att {
constexpr int NW = 8, QBLK = 32, KVBLK = 64, QB = 256;
constexpr int SHM_V = 16384, SHM_K = KVBLK * 384;
constexpr int OFF_V = 0, OFF_K = 2 * SHM_V, OFF_WS = OFF_K + 2 * SHM_K;
constexpr int LDS_ATT = OFF_WS + NW * 64 * 4;
static_assert(LDS_ATT <= RING_BYTES, "attention LDS");
constexpr int QPITCH = NH * QKD, KVPITCH = NH * 256, KRPITCH = NH * ROPE, OPITCH = NH * VD;
constexpr float THR = 8.f;
#define SBAR() __builtin_amdgcn_sched_barrier(0)
__device__ __forceinline__ int v_st(int k, int c) { const int kk = (k & ~0xC) | ((k & 4) << 1) | ((k & 8) >> 1); return ((kk >> 3) * 4 + (c >> 5)) * 512 + ((kk & 7) * 32 + (c & 31)) * 2; }
__device__ __forceinline__ int v_rd_base(int lane) { return ((lane & 3) << 3) | (((lane >> 2) & 3) << 6) | (((lane >> 4) & 1) << 5) | (((lane >> 5) & 1) << 8); }
constexpr int v_rd_off(int d0, int ks, int half) { return d0 * 512 + ks * 4096 + half * 2048; }
__device__ __forceinline__ int crow(int r, int hi) { return (r & 3) + 8 * (r >> 2) + 4 * hi; }

template <int KB>
__device__ __forceinline__ void qkt(f32x16& p0, f32x16& p1, const LAS char* const* kbv, const bf16x8* qr) {
    p0 = (f32x16){0.f, 0.f, 0.f, 0.f, 0.f, 0.f, 0.f, 0.f, 0.f, 0.f, 0.f, 0.f, 0.f, 0.f, 0.f, 0.f}; p1 = p0;
#pragma unroll
    for (int d0 = 0; d0 < 12; ++d0) {
        const bf16x8 a0 = *(const LAS bf16x8*)(kbv[d0 & 3] + KB * SHM_K + (d0 >> 2) * 128);
        const bf16x8 a1 = *(const LAS bf16x8*)(kbv[d0 & 3] + KB * SHM_K + (d0 >> 2) * 128 + 32 * 384);
        p0 = __builtin_amdgcn_mfma_f32_32x32x16_bf16(a0, qr[d0], p0, 0, 0, 0);
        p1 = __builtin_amdgcn_mfma_f32_32x32x16_bf16(a1, qr[d0], p1, 0, 0, 0);
    }
}
__device__ __forceinline__ void mask_tile(f32x16& p0, f32x16& p1, int dq) {
    const float NEG = -__builtin_inff();
#pragma unroll
    for (int r = 0; r < 16; ++r) { const int c = (r & 3) + 8 * (r >> 2); if (c > dq) p0[r] = NEG; if (c + 32 > dq) p1[r] = NEG; }
}
__device__ __forceinline__ void softmax_tile(f32x16& p0, f32x16& p1, float& m_reg, float& l_reg, float& alpha, bf16x8& pa0, bf16x8& pa1, bf16x8& pa2, bf16x8& pa3) {
    float pmax = p0[0];
#pragma unroll
    for (int r = 1; r < 16; ++r) pmax = fmaxf(pmax, p0[r]);
#pragma unroll
    for (int r = 0; r < 16; ++r) pmax = fmaxf(pmax, p1[r]);
    { auto rr = __builtin_amdgcn_permlane32_swap(__float_as_uint(pmax), __float_as_uint(pmax), false, false); pmax = fmaxf(__uint_as_float(rr[0]), __uint_as_float(rr[1])); }
    float mn;
    if (__all(pmax - m_reg <= THR)) { mn = m_reg; alpha = 1.f; }
    else { mn = fmaxf(m_reg, pmax); alpha = __builtin_amdgcn_exp2f(m_reg - mn); m_reg = mn; }
    float ps = 0.f;
#pragma unroll
    for (int r = 0; r < 16; ++r) { p0[r] = __builtin_amdgcn_exp2f(p0[r] - mn); ps += p0[r]; }
#pragma unroll
    for (int r = 0; r < 16; ++r) { p1[r] = __builtin_amdgcn_exp2f(p1[r] - mn); ps += p1[r]; }
    { auto rr = __builtin_amdgcn_permlane32_swap(__float_as_uint(ps), __float_as_uint(ps), false, false); ps = __uint_as_float(rr[0]) + __uint_as_float(rr[1]); }
    l_reg = l_reg * alpha + ps;
#define PK4(P, B_, OUT) do { unsigned a0 = cvtpk(P[B_+0], P[B_+1]), a1 = cvtpk(P[B_+2], P[B_+3]); unsigned b0 = cvtpk(P[B_+4], P[B_+5]), b1 = cvtpk(P[B_+6], P[B_+7]); \
        auto r0 = __builtin_amdgcn_permlane32_swap(a0, b0, false, false); auto r1 = __builtin_amdgcn_permlane32_swap(a1, b1, false, false); \
        u32x4 w = {r0[0], r1[0], r0[1], r1[1]}; OUT = __builtin_bit_cast(bf16x8, w); } while (0)
    PK4(p0, 0, pa0); PK4(p0, 8, pa1); PK4(p1, 0, pa2); PK4(p1, 8, pa3);
#undef PK4
}
template <int VB>
__device__ __forceinline__ void pv_tile(f32x16* o, unsigned vb0, bf16x8 pa0, bf16x8 pa1, bf16x8 pa2, bf16x8 pa3) {
#define TRRD(dst, off) asm volatile("ds_read_b64_tr_b16 %0, %1 offset:%2" : "=&v"(dst) : "v"(vb0), "i"(off) : "memory")
#define PV_D0(d0) do { s16x4 l0, l1, l2, l3, h0, h1, h2, h3; constexpr int b_ = VB * SHM_V + v_rd_off(d0, 0, 0); \
        TRRD(l0, b_); TRRD(h0, b_ + 2048); TRRD(l1, b_ + 4096); TRRD(h1, b_ + 6144); TRRD(l2, b_ + 8192); TRRD(h2, b_ + 10240); TRRD(l3, b_ + 12288); TRRD(h3, b_ + 14336); \
        asm volatile("s_waitcnt lgkmcnt(0)" ::: "memory"); SBAR(); \
        o[d0] = __builtin_amdgcn_mfma_f32_32x32x16_bf16(pa0, (bf16x8){l0[0], l0[1], l0[2], l0[3], h0[0], h0[1], h0[2], h0[3]}, o[d0], 0, 0, 0); \
        o[d0] = __builtin_amdgcn_mfma_f32_32x32x16_bf16(pa1, (bf16x8){l1[0], l1[1], l1[2], l1[3], h1[0], h1[1], h1[2], h1[3]}, o[d0], 0, 0, 0); \
        o[d0] = __builtin_amdgcn_mfma_f32_32x32x16_bf16(pa2, (bf16x8){l2[0], l2[1], l2[2], l2[3], h2[0], h2[1], h2[2], h2[3]}, o[d0], 0, 0, 0); \
        o[d0] = __builtin_amdgcn_mfma_f32_32x32x16_bf16(pa3, (bf16x8){l3[0], l3[1], l3[2], l3[3], h3[0], h3[1], h3[2], h3[3]}, o[d0], 0, 0, 0); } while (0)
    PV_D0(0); PV_D0(1); PV_D0(2); PV_D0(3);
#undef PV_D0
#undef TRRD
}

__device__ __forceinline__ void attn_unit(int h, int qb, const bf16_t* Q, const bf16_t* K2, const bf16_t* KV, bf16_t* O, LAS char* lds, const float* gq, const float* tab) {
    const int tid = threadIdx.x, wid = __builtin_amdgcn_readfirstlane(tid >> 6), lane = tid & 63, r32 = lane & 31, hi = lane >> 5;
    const int NT = (qb + 1) * 4;
    const int qlo = qb * QB + wid * QBLK;
    LAS float* wsf = (LAS float*)(lds + OFF_WS) + wid * 64; LAS float* li_l = wsf; LAS float* al_l = wsf + 32;
    const char* baseK = (const char*)(K2 + h * QKD); const char* baseV = (const char*)(KV + h * 256 + 128);
    unsigned offK[3], offV[2];
#pragma unroll
    for (int i = 0; i < 3; ++i) { const int b = (wid + 8 * i) * 1024 + lane * 16, row = b / 384, cp = (b % 384) / 16, ch = (cp & ~7) | ((cp & 7) ^ ((row >> 1) & 7)); offK[i] = (unsigned)(row * QPITCH * 2 + ch * 16); }
#pragma unroll
    for (int i = 0; i < 2; ++i) { const int b = (wid + 8 * i) * 1024 + lane * 16, st = b >> 9, kk = (st >> 2) * 8 + ((b & 511) >> 6), c = (st & 3) * 32 + ((b & 63) >> 1);
        const int k = (kk & ~0xC) | ((kk & 4) << 1) | ((kk & 8) >> 1); offV[i] = (unsigned)(k * KVPITCH * 2 + c * 2); }
    const unsigned vb0 = (unsigned)(uintptr_t)(lds + OFF_V) + v_rd_base(lane);
    const LAS char* kbv[4];
#pragma unroll
    for (int dd = 0; dd < 4; ++dd) kbv[dd] = lds + OFF_K + r32 * 384 + (((2 * dd + hi) ^ ((r32 >> 1) & 7)) << 4);
    bf16x8 qr[12];
    {
      const bf16_t* qp = Q + (size_t)(qlo + r32) * QPITCH + h * QKD + hi * 8;
      u32x4 qw[12];
#pragma unroll
      for (int d0 = 0; d0 < 12; ++d0) qw[d0] = *(const u32x4*)(qp + d0 * 16);
      float ssq = 0.f;
#pragma unroll
      for (int d0 = 0; d0 < 12; ++d0) { const u32x4 w = qw[d0]; const float f[8] = {bflo(w.x), bfhi(w.x), bflo(w.y), bfhi(w.y), bflo(w.z), bfhi(w.z), bflo(w.w), bfhi(w.w)};
#pragma unroll
          for (int j = 0; j < 8; ++j) ssq += f[j] * f[j]; }
      { const auto r_ = __builtin_amdgcn_permlane32_swap(__builtin_bit_cast(unsigned, ssq), __builtin_bit_cast(unsigned, ssq), false, false); ssq = __builtin_bit_cast(float, (unsigned)r_[0]) + __builtin_bit_cast(float, (unsigned)r_[1]); }
      const float rq = rsqrtf(ssq * (1.f / QKD) + EPS) * (0.07216878364870322f * 1.4426950408889634f);
      const float* tb = tab + (size_t)(qlo + r32) * 64 + 8 * hi;
#pragma unroll
      for (int d0 = 0; d0 < 8; ++d0) { const u32x4 w = qw[d0]; const float* gp = gq + 16 * d0 + 8 * hi; const f32x4 g0 = *(const f32x4*)gp, g1 = *(const f32x4*)(gp + 4);
          u32x4 o; o.x = cvtpk(bflo(w.x) * rq * g0.x, bfhi(w.x) * rq * g0.y); o.y = cvtpk(bflo(w.y) * rq * g0.z, bfhi(w.y) * rq * g0.w); o.z = cvtpk(bflo(w.z) * rq * g1.x, bfhi(w.z) * rq * g1.y); o.w = cvtpk(bflo(w.w) * rq * g1.z, bfhi(w.w) * rq * g1.w);
          qr[d0] = __builtin_bit_cast(bf16x8, o); }
#pragma unroll
      for (int dd = 0; dd < 2; ++dd) { const u32x4 wa = qw[8 + dd], wb = qw[10 + dd];
          const float* ga = gq + 128 + 16 * dd + 8 * hi; const f32x4 ga0 = *(const f32x4*)ga, ga1 = *(const f32x4*)(ga + 4), gb0 = *(const f32x4*)(ga + 32), gb1 = *(const f32x4*)(ga + 36);
          const f32x4 c0 = *(const f32x4*)(tb + 16 * dd), c1 = *(const f32x4*)(tb + 16 * dd + 4), s0 = *(const f32x4*)(tb + 32 + 16 * dd), s1 = *(const f32x4*)(tb + 32 + 16 * dd + 4);
          const float fa[8] = {bflo(wa.x), bfhi(wa.x), bflo(wa.y), bfhi(wa.y), bflo(wa.z), bfhi(wa.z), bflo(wa.w), bfhi(wa.w)}, fb[8] = {bflo(wb.x), bfhi(wb.x), bflo(wb.y), bfhi(wb.y), bflo(wb.z), bfhi(wb.z), bflo(wb.w), bfhi(wb.w)};
          const float gA[8] = {ga0.x, ga0.y, ga0.z, ga0.w, ga1.x, ga1.y, ga1.z, ga1.w}, gB[8] = {gb0.x, gb0.y, gb0.z, gb0.w, gb1.x, gb1.y, gb1.z, gb1.w};
          const float cs[8] = {c0.x, c0.y, c0.z, c0.w, c1.x, c1.y, c1.z, c1.w}, sn[8] = {s0.x, s0.y, s0.z, s0.w, s1.x, s1.y, s1.z, s1.w};
          float oa[8], ob[8];
#pragma unroll
          for (int j = 0; j < 8; ++j) { const float a = fa[j] * rq * gA[j], b = fb[j] * rq * gB[j]; oa[j] = a * cs[j] - b * sn[j]; ob[j] = b * cs[j] + a * sn[j]; }
          u32x4 o; o.x = cvtpk(oa[0], oa[1]); o.y = cvtpk(oa[2], oa[3]); o.z = cvtpk(oa[4], oa[5]); o.w = cvtpk(oa[6], oa[7]); qr[8 + dd] = __builtin_bit_cast(bf16x8, o);
          o.x = cvtpk(ob[0], ob[1]); o.y = cvtpk(ob[2], ob[3]); o.z = cvtpk(ob[4], ob[5]); o.w = cvtpk(ob[6], ob[7]); qr[10 + dd] = __builtin_bit_cast(bf16x8, o); } }
#define SLOAD(t, bf) do { const char* bk_ = baseK + (size_t)(t) * (KVBLK * QPITCH * 2); const char* bv_ = baseV + (size_t)(t) * (KVBLK * KVPITCH * 2); \
        _Pragma("unroll") for (int i_ = 0; i_ < 3; ++i_) __builtin_amdgcn_global_load_lds((const unsigned*)(bk_ + offK[i_]), (LAS unsigned*)(lds + OFF_K + (bf) * SHM_K + (wid + 8 * i_) * 1024), 16, 0, 0); \
        _Pragma("unroll") for (int i_ = 0; i_ < 2; ++i_) __builtin_amdgcn_global_load_lds((const unsigned*)(bv_ + offV[i_]), (LAS unsigned*)(lds + OFF_V + (bf) * SHM_V + (wid + 8 * i_) * 1024), 16, 0, 0); } while (0)
    float m_reg = -1e30f, l_reg = 0.f;
    f32x16 o[4];
#pragma unroll
    for (int d = 0; d < 4; ++d) o[d] = (f32x16){0.f, 0.f, 0.f, 0.f, 0.f, 0.f, 0.f, 0.f, 0.f, 0.f, 0.f, 0.f, 0.f, 0.f, 0.f, 0.f};
#define STEP(t, BUF) do { const int kbase_ = (t) * KVBLK; if (kbase_ <= qlo + QBLK - 1) { f32x16 p0, p1; bf16x8 pa0, pa1, pa2, pa3; float alpha; \
        qkt<BUF>(p0, p1, kbv, qr); \
        if (kbase_ + KVBLK - 1 > qlo) mask_tile(p0, p1, qlo + r32 - kbase_ - 4 * hi); \
        softmax_tile(p0, p1, m_reg, l_reg, alpha, pa0, pa1, pa2, pa3); \
        if (__any(alpha < 1.f)) { if (hi == 0) al_l[r32] = alpha; asm volatile("s_waitcnt lgkmcnt(0)" ::: "memory"); \
            _Pragma("unroll") for (int r = 0; r < 16; ++r) { const float a_ = al_l[crow(r, hi)]; _Pragma("unroll") for (int d_ = 0; d_ < 4; ++d_) o[d_][r] *= a_; } } \
        SBAR(); pv_tile<BUF>(o, vb0, pa0, pa1, pa2, pa3); } } while (0)
    SLOAD(0, 0); VM_WAIT(); __syncthreads();
    for (int t = 0; t < NT; t += 2) {
        SLOAD(t + 1, 1);
        STEP(t, 0);
        VM_WAIT(); __syncthreads();
        if (t + 2 < NT) SLOAD(t + 2, 0);
        STEP(t + 1, 1);
        VM_WAIT(); __syncthreads();
    }
    if (hi == 0) li_l[r32] = l_reg;
    asm volatile("s_waitcnt lgkmcnt(0)" ::: "memory");
    int lane_e = lane; asm volatile("" : "+v"(lane_e));
    const int r32e = lane_e & 31, hie = lane_e >> 5;
    bf16_t* Ow = O + (size_t)qlo * OPITCH + h * VD;
#pragma unroll
    for (int r = 0; r < 16; ++r) { const int orow = crow(r, hie); const float rl = __builtin_amdgcn_rcpf(li_l[orow]);
#pragma unroll
        for (int d0 = 0; d0 < 4; ++d0) { const float v = o[d0][r] * rl; const float vn = __shfl_xor(v, 1);
            if ((r32e & 1) == 0) *(unsigned*)(Ow + (size_t)orow * OPITCH + d0 * 32 + r32e) = cvtpk(v, vn); } }
    __syncthreads();
#undef SLOAD
#undef STEP
}
#undef SBAR
}

struct Args {
    const float* in[36]; float* out; unsigned char* ws;
    float inv_freq[32];
    int ph_lo, ph_hi, li, pad;
};
struct Frame { LAS unsigned char* lds; int tid, lane, wave, G, gw, NGW; unsigned char* ws; };

enum { I_X = 0, I_P, I_POS, I_GMIX, I_WIN, I_GQA, I_WQB, I_GKVA, I_WKVB, I_GQH, I_GKH, I_MU, I_W0, I_W2, I_A0, I_A2, I_G2, I_KK, I_KA, I_RK, I_LNG, I_LNB,
       I_WBR, I_WOUT, I_GFFN, I_WGRP, I_BGRP, I_WEXP, I_BEXP, I_WEG, I_WEU, I_WED, I_GPLE, I_WPG, I_WPP, I_GPP };

__device__ __forceinline__ void transpose_item(const float* W, int ldw, int Kvalid, int k0, int n0, bf16_t* WT, size_t ldt, int drow0, const float* kscale, LAS float* scr, int lane) {
#pragma unroll 8
    for (int i = 0; i < 32; ++i) { const int kk = 2 * i + (lane >> 5); const int k = k0 + kk;
        float v = 0.f; if (k < Kvalid) { v = W[(size_t)k * ldw + n0 + (lane & 31)]; if (kscale) v *= kscale[k]; }
        scr[kk * 33 + (lane & 31)] = v; }
    LDS_WAIT(); asm volatile("" ::: "memory");
    const int c = lane & 7;
#pragma unroll
    for (int j = 0; j < 4; ++j) { const int n = (lane >> 3) + 8 * j; const LAS float* s = scr + (8 * c) * 33 + n;
        u32x4 o; o.x = pk2(s[0 * 33], s[1 * 33]); o.y = pk2(s[2 * 33], s[3 * 33]); o.z = pk2(s[4 * 33], s[5 * 33]); o.w = pk2(s[6 * 33], s[7 * 33]);
        *(u32x4*)(WT + (size_t)(drow0 + n) * ldt + k0 + 8 * c) = o; }
    LDS_WAIT(); asm volatile("" ::: "memory");
}
__device__ __forceinline__ void transpose_mat_item(const float* W, int Kvalid, int Kpad, int N, bf16_t* WT, const float* kscale, int it, LAS float* scr, int lane) {
    const int nblk = N / 32, kb = it / nblk, nb = it % nblk;
    transpose_item(W, N, Kvalid, 64 * kb, 32 * nb, WT, (size_t)Kpad, 32 * nb, kscale, scr, lane);
}
__device__ __forceinline__ void transpose64_item(const float* W, int ldw, int k0, int n0, bf16_t* WT, size_t ldt, int drow0, const float* kscale, LAS unsigned* scr, int lane) {
    const int kr = lane >> 4, c4 = lane & 15;
    f32x4 ra[8], rb[8];
#pragma unroll
    for (int i = 0; i < 8; ++i) { const float* p = W + (size_t)(k0 + 8 * i + 2 * kr) * ldw + n0 + 4 * c4; ra[i] = __builtin_nontemporal_load((const f32x4*)p); rb[i] = __builtin_nontemporal_load((const f32x4*)(p + ldw)); }
    if (kscale) {
#pragma unroll
        for (int i = 0; i < 8; ++i) { const float s0 = kscale[k0 + 8 * i + 2 * kr], s1 = kscale[k0 + 8 * i + 2 * kr + 1]; ra[i] = ra[i] * s0; rb[i] = rb[i] * s1; } }
#pragma unroll
    for (int i = 0; i < 8; ++i)
#pragma unroll
        for (int e = 0; e < 4; ++e) { const int n = 4 * c4 + e; scr[n * 32 + ((4 * i + kr) ^ (4 * (c4 & 7)))] = cvtpk(ra[i][e], rb[i][e]); }
    LDS_WAIT(); asm volatile("" ::: "memory");
#pragma unroll
    for (int j = 0; j < 8; ++j) { const int id = lane + 64 * j, n = id >> 3, ch = id & 7;
        const u32x4 v = *(const LAS u32x4*)(scr + n * 32 + ((ch ^ ((n >> 2) & 7)) << 2));
        *(u32x4*)(WT + (size_t)(drow0 + n) * ldt + k0 + ch * 8) = v; }
    LDS_WAIT(); asm volatile("" ::: "memory");
}
__device__ __forceinline__ void transpose64_mat_item(const float* W, int K, int N, bf16_t* WT, const float* kscale, int it, LAS unsigned* scr, int lane) {
    const int nblk = N / 64, kb = it / nblk, nb = it % nblk;
    transpose64_item(W, N, 64 * kb, 64 * nb, WT, (size_t)K, 64 * nb, kscale, scr, lane);
}
__device__ __forceinline__ void norm_row_bf16(const float* xrow, const float* g, bf16_t* orow, int lane) {
    const f32x4* xr = (const f32x4*)xrow + lane; f32x4 v[8]; float s = 0.f;
#pragma unroll
    for (int j = 0; j < 8; ++j) { v[j] = xr[64 * j]; s += (v[j].x * v[j].x + v[j].y * v[j].y) + (v[j].z * v[j].z + v[j].w * v[j].w); }
    const float rstd = rsqrtf(wave_sum(s) * (1.f / DM) + EPS);
    u32x2* o8 = (u32x2*)orow + lane;
#pragma unroll
    for (int j = 0; j < 8; ++j) { const f32x4 gg = ((const f32x4*)g)[lane + 64 * j]; u32x2 w; w.x = cvtpk(v[j].x * rstd * gg.x, v[j].y * rstd * gg.y); w.y = cvtpk(v[j].z * rstd * gg.z, v[j].w * rstd * gg.w); o8[64 * j] = w; }
}
__device__ __forceinline__ void norm_row2_bf16(const float* xa, const float* xb, const float* g, bf16_t* oa, bf16_t* ob, int lane) {
    const f32x4* ra = (const f32x4*)xa + lane; const f32x4* rb = (const f32x4*)xb + lane; f32x4 va[8], vb[8]; float sa = 0.f, sb = 0.f;
#pragma unroll
    for (int j = 0; j < 8; ++j) { va[j] = ra[64 * j]; vb[j] = rb[64 * j]; }
#pragma unroll
    for (int j = 0; j < 8; ++j) { sa += (va[j].x * va[j].x + va[j].y * va[j].y) + (va[j].z * va[j].z + va[j].w * va[j].w); sb += (vb[j].x * vb[j].x + vb[j].y * vb[j].y) + (vb[j].z * vb[j].z + vb[j].w * vb[j].w); }
#pragma unroll
    for (int o = 1; o < 64; o <<= 1) { sa += __shfl_xor(sa, o); sb += __shfl_xor(sb, o); }
    const float rsa = rsqrtf(sa * (1.f / DM) + EPS), rsb = rsqrtf(sb * (1.f / DM) + EPS);
    u32x2* pa = (u32x2*)oa + lane; u32x2* pb = (u32x2*)ob + lane;
#pragma unroll
    for (int j = 0; j < 8; ++j) { const f32x4 gg = ((const f32x4*)g)[lane + 64 * j]; u32x2 w; w.x = cvtpk(va[j].x * rsa * gg.x, va[j].y * rsa * gg.y); w.y = cvtpk(va[j].z * rsa * gg.z, va[j].w * rsa * gg.w); pa[64 * j] = w;
        w.x = cvtpk(vb[j].x * rsb * gg.x, vb[j].y * rsb * gg.y); w.y = cvtpk(vb[j].z * rsb * gg.z, vb[j].w * rsb * gg.w); pb[64 * j] = w; }
}
__device__ __forceinline__ void norm_brow2_bf16(const bf16_t* xa, const bf16_t* xb, const float* g, bf16_t* oa, bf16_t* ob, int lane) {
    const u32x2* ra = (const u32x2*)xa + lane; const u32x2* rb = (const u32x2*)xb + lane; u32x2 wa[8], wb[8]; float sa = 0.f, sb = 0.f;
#pragma unroll
    for (int j = 0; j < 8; ++j) { wa[j] = ra[64 * j]; wb[j] = rb[64 * j]; }
#pragma unroll
    for (int j = 0; j < 8; ++j) { const float a0 = bflo(wa[j].x), a1 = bfhi(wa[j].x), a2 = bflo(wa[j].y), a3 = bfhi(wa[j].y), b0 = bflo(wb[j].x), b1 = bfhi(wb[j].x), b2 = bflo(wb[j].y), b3 = bfhi(wb[j].y);
        sa += (a0 * a0 + a1 * a1) + (a2 * a2 + a3 * a3); sb += (b0 * b0 + b1 * b1) + (b2 * b2 + b3 * b3); }
#pragma unroll
    for (int o = 1; o < 64; o <<= 1) { sa += __shfl_xor(sa, o); sb += __shfl_xor(sb, o); }
    const float rsa = rsqrtf(sa * (1.f / DM) + EPS), rsb = rsqrtf(sb * (1.f / DM) + EPS);
    u32x2* pa = (u32x2*)oa + lane; u32x2* pb = (u32x2*)ob + lane;
#pragma unroll
    for (int j = 0; j < 8; ++j) { const f32x4 gg = ((const f32x4*)g)[lane + 64 * j]; u32x2 w;
        w.x = cvtpk(bflo(wa[j].x) * rsa * gg.x, bfhi(wa[j].x) * rsa * gg.y); w.y = cvtpk(bflo(wa[j].y) * rsa * gg.z, bfhi(wa[j].y) * rsa * gg.w); pa[64 * j] = w;
        w.x = cvtpk(bflo(wb[j].x) * rsb * gg.x, bfhi(wb[j].x) * rsb * gg.y); w.y = cvtpk(bflo(wb[j].y) * rsb * gg.z, bfhi(wb[j].y) * rsb * gg.w); pb[64 * j] = w; }
}
__device__ __forceinline__ void unpack8(u32x4 w, float* f) { f[0] = bflo(w.x); f[1] = bfhi(w.x); f[2] = bflo(w.y); f[3] = bfhi(w.y); f[4] = bflo(w.z); f[5] = bfhi(w.z); f[6] = bflo(w.w); f[7] = bfhi(w.w); }

__device__ __forceinline__ float fmix_lo(float a, unsigned spk, float c) { float d; asm("v_fma_mix_f32 %0, %1, %2, %3 op_sel_hi:[0,1,0]" : "=v"(d) : "v"(a), "s"(spk), "v"(c)); return d; }
__device__ __forceinline__ float fmix_hi(float a, unsigned spk, float c) { float d; asm("v_fma_mix_f32 %0, %1, %2, %3 op_sel:[0,1,0] op_sel_hi:[0,1,0]" : "=v"(d) : "v"(a), "s"(spk), "v"(c)); return d; }
__device__ __forceinline__ float vmix_lo(float a, unsigned vpk, float c) { float d; asm("v_fma_mix_f32 %0, %1, %2, %3 op_sel_hi:[0,1,0]" : "=v"(d) : "v"(a), "v"(vpk), "v"(c)); return d; }
__device__ __forceinline__ float vmix_hi(float a, unsigned vpk, float c) { float d; asm("v_fma_mix_f32 %0, %1, %2, %3 op_sel:[0,1,0] op_sel_hi:[0,1,0]" : "=v"(d) : "v"(a), "v"(vpk), "v"(c)); return d; }
__device__ __forceinline__ float fmul_s(float a, unsigned sw) { float d; asm("v_mul_f32 %0, %1, %2" : "=v"(d) : "s"(sw), "v"(a)); return d; }
typedef unsigned u32x16 __attribute__((ext_vector_type(16)));
typedef const u32x16 __attribute__((address_space(4)))* c16p;
constexpr int R2_STEP = 1792, R2_WAVE_LDS = 16384, R2_PIECE = 4 * R2_STEP;
struct R2Stage { u32x2 zr, zrp, zk, zkp, zv, zvp, aa; f32x4 lw; };
struct R2Src { const bf16_t* proj; const bf16_t* AA; const float* LW; };
__device__ __forceinline__ void r2_load(R2Stage& st, const R2Src& S, int unit, int piece, int lane) {
    const int c = unit >> 4, hh = unit & 15, t = c * 64 + piece * 4 + (lane >> 4), ch = hh * 64 + 4 * (lane & 15);
    const bf16_t* row = S.proj + (size_t)t * IN_TOTAL + MLA_IN + ch; const bf16_t* prow = (t > 0) ? row - IN_TOTAL : row;
    st.zr = *(const u32x2*)row; st.zrp = *(const u32x2*)prow; st.zk = *(const u32x2*)(row + RW); st.zkp = *(const u32x2*)(prow + RW);
    st.aa = *(const u32x2*)(S.AA + (size_t)t * RW + ch); st.lw = *(const f32x4*)(S.LW + (size_t)t * RW + ch);
    st.zv = *(const u32x2*)(row + 2 * RW); st.zvp = *(const u32x2*)(prow + 2 * RW);
}
__device__ __forceinline__ void r2_bf4(u32x2 v, float* f) { f[0] = bflo(v.x); f[1] = bfhi(v.x); f[2] = bflo(v.y); f[3] = bfhi(v.y); }
typedef __bf16 bf16v2 __attribute__((ext_vector_type(2)));
__device__ __forceinline__ unsigned cvtpk_c(float lo, float hi) { return __builtin_bit_cast(unsigned, __builtin_convertvector((f32x2){lo, hi}, bf16v2)); }
__device__ __forceinline__ u32x2 r2_hilo_a(float x) { const unsigned h = cvtpk_c(x, 0.f); const float xh = __builtin_bit_cast(float, h << 16); const unsigned l = cvtpk_c(0.f, x - xh); return (u32x2){h | l, h}; }
__device__ __forceinline__ u32x2 r2_hilo_b(float y) { const unsigned h = cvtpk_c(y, y); const float yh = __builtin_bit_cast(float, h & 0xffff0000u); const unsigned l = cvtpk_c(y - yh, 0.f); return (u32x2){h, l}; }
__device__ __forceinline__ f32x16 r2_mfma(u32x4 a, u32x4 b, f32x16 c) { return __builtin_amdgcn_mfma_f32_32x32x16_bf16(__builtin_bit_cast(bf16x8, a), __builtin_bit_cast(bf16x8, b), c, 0, 0, 0); }
__device__ __forceinline__ u32x4 r2_aop(const LAS unsigned char* p, int dlt) { const u32x2 lo = *(const LAS u32x2*)p, hi = *(const LAS u32x2*)(p + dlt); return (u32x4){lo.x, lo.y, hi.x, hi.y}; }
__device__ __forceinline__ void r2_write(const R2Stage& st, LAS unsigned char* buf, const LAS float* cst, int lane, bool reset, bool last, bool first) {
    const int s_ = lane >> 4, cg = lane & 15;
    const f32x4 mur = *(const LAS f32x4*)(cst + 4 * cg), muk = *(const LAS f32x4*)(cst + 64 + 4 * cg), kkc = *(const LAS f32x4*)(cst + 128 + 4 * cg), kac = *(const LAS f32x4*)(cst + 192 + 4 * cg), muv = *(const LAS f32x4*)(cst + 256 + 4 * cg);
    float zr[4], zrp[4], zk[4], zkp[4], zv[4], zvp[4], aa[4]; r2_bf4(st.zr, zr); r2_bf4(st.zrp, zrp); r2_bf4(st.zk, zk); r2_bf4(st.zkp, zkp); r2_bf4(st.zv, zv); r2_bf4(st.zvp, zvp); r2_bf4(st.aa, aa);
    if (first && s_ == 0) {
#pragma unroll
        for (int j = 0; j < 4; ++j) { zrp[j] = 0.f; zkp[j] = 0.f; zvp[j] = 0.f; } }
    float r[4], k[4], kk[4], ss = 0.f;
#pragma unroll
    for (int j = 0; j < 4; ++j) { r[j] = zr[j] + (zrp[j] - zr[j]) * mur[j]; k[j] = zk[j] + (zkp[j] - zk[j]) * muk[j]; kk[j] = k[j] * kkc[j]; ss += kk[j] * kk[j]; }
    ss += __builtin_bit_cast(float, __builtin_amdgcn_update_dpp(0, __builtin_bit_cast(int, ss), 0xB1, 0xF, 0xF, true));
    ss += __builtin_bit_cast(float, __builtin_amdgcn_update_dpp(0, __builtin_bit_cast(int, ss), 0x4E, 0xF, 0xF, true));
    ss += __builtin_bit_cast(float, __builtin_amdgcn_update_dpp(0, __builtin_bit_cast(int, ss), 0x141, 0xF, 0xF, true));
    ss += __builtin_bit_cast(float, __builtin_amdgcn_update_dpp(0, __builtin_bit_cast(int, ss), 0x140, 0xF, 0xF, true));
    const float rn = rsqrtf(ss + 1e-12f);
    f32x4 cum = st.lw;
#pragma unroll
    for (int j = 0; j < 4; ++j) { const float t1 = __shfl_up(cum[j], 16); if (s_ >= 1) cum[j] += t1; }
#pragma unroll
    for (int j = 0; j < 4; ++j) { const float t2 = __shfl_up(cum[j], 32); if (s_ >= 2) cum[j] += t2; }
    LAS f32x4* cslot = (LAS f32x4*)((LAS unsigned char*)cst + 1536 + cg * 16);
    f32x4 carry = *cslot; if (reset) carry = (f32x4){0.f, 0.f, 0.f, 0.f};
    cum += carry;
    if (s_ == 3) *cslot = cum;
    f32x4 av, bv, kv, rv, wv;
#pragma unroll
    for (int j = 0; j < 4; ++j) { const float kn = kk[j] * rn, W = __expf(cum[j]), iW = __expf(-cum[j]), Wm = __expf(cum[j] - st.lw[j]);
        av[j] = -kn * Wm; bv[j] = kn * aa[j] * iW; kv[j] = k[j] * (1.f + (aa[j] - 1.f) * kac[j]) * iW; rv[j] = r[j] * W; wv[j] = W; }
    LAS unsigned char* d = buf + s_ * R2_STEP + cg * 16;
    *(LAS f32x4*)d = av; *(LAS f32x4*)(d + 768) = rv;
    if (last && s_ == 3) *(LAS f32x4*)((LAS unsigned char*)cst + 1280 + cg * 16) = wv;
    *(LAS f32x4*)(d + 1536) = (f32x4){zv[0] + (zvp[0] - zv[0]) * muv[0], zv[1] + (zvp[1] - zv[1]) * muv[1], zv[2] + (zvp[2] - zv[2]) * muv[2], zv[3] + (zvp[3] - zv[3]) * muv[3]};
    u32x4 b01, b23, k01, k23;
    { const u32x2 t0 = r2_hilo_a(bv[0]), t1 = r2_hilo_a(bv[1]), t2 = r2_hilo_a(bv[2]), t3 = r2_hilo_a(bv[3]); b01 = (u32x4){t0.x, t0.y, t1.x, t1.y}; b23 = (u32x4){t2.x, t2.y, t3.x, t3.y}; }
    { const u32x2 t0 = r2_hilo_a(kv[0]), t1 = r2_hilo_a(kv[1]), t2 = r2_hilo_a(kv[2]), t3 = r2_hilo_a(kv[3]); k01 = (u32x4){t0.x, t0.y, t1.x, t1.y}; k23 = (u32x4){t2.x, t2.y, t3.x, t3.y}; }
    LAS unsigned char* d2 = buf + s_ * R2_STEP + cg * 32;
    *(LAS u32x4*)(d2 + 256) = b01; *(LAS u32x4*)(d2 + 272) = b23; *(LAS u32x4*)(d2 + 1024) = k01; *(LAS u32x4*)(d2 + 1040) = k23;
}
__device__ __forceinline__ void swap32(float& x, float& y) {
    const auto r = __builtin_amdgcn_permlane32_swap(__builtin_bit_cast(unsigned, x), __builtin_bit_cast(unsigned, y), false, false);
    x = __builtin_bit_cast(float, (unsigned)r[0]); y = __builtin_bit_cast(float, (unsigned)r[1]); }
template <int VAR>
__device__ __forceinline__ void r2_wave(int gw, int NGW, int lane, LAS unsigned char* wl, const R2Src S, const float* mu, const float* kkp, const float* kap, float* YR, _Float16* QQ, bf16_t* PT, float* LL) {
    constexpr int NU = (T / 64) * RH, NP = 16;
    int unit = gw; if (unit >= NU) return;
    LAS float* cst = (LAS float*)(wl + 2 * R2_PIECE);
    { const int hc = (unit & 15) * 64 + lane; cst[lane] = mu[hc]; cst[64 + lane] = mu[RW + hc]; cst[128 + lane] = kkp[hc]; cst[192 + lane] = kap[hc]; cst[256 + lane] = mu[2 * RW + hc]; }
    asm volatile("s_waitcnt lgkmcnt(0)" ::: "memory");
    R2Stage st; r2_load(st, S, unit, 0, lane); r2_write(st, wl, cst, lane, true, false, unit < 16);
    int pcount = 0;
    for (; unit < NU; unit += NGW) {
        const int c = unit >> 4, hh = unit & 15;
        f32x16 X[4][2];
        int ln = lane; asm volatile("" : "+v"(ln));
        const int hf = ln >> 5, n = ln & 31;
#pragma unroll
        for (int blk = 0; blk < 4; ++blk)
#pragma unroll
            for (int jb = 0; jb < 2; ++jb)
#pragma unroll
                for (int i = 0; i < 16; ++i) X[blk][jb][i] = (blk < 2 && (32 * jb + 8 * (i >> 2) + 4 * hf + (i & 3)) == n + 32 * blk) ? 1.f : 0.f;
        const LAS unsigned char* rprev = wl + hf * 16 + 768;
        u32x4 Bt0 = (u32x4){0u, 0u, 0u, 0u}, Bt1 = Bt0, Bt2 = Bt0, Bt3 = Bt0;
        const int adl = (n == 31) ? -8 : 8;
        const LAS unsigned char* aprev = wl + 256 + hf * 768 + 256 + n * 8;
        for (int piece = 0; piece < NP; ++piece, ++pcount) {
            int nu = unit, np = piece + 1; if (np == NP) { np = 0; nu = unit + NGW; }
            const bool spare = nu >= NU;
            if (spare) { nu = unit; np = NP - 1; }
            r2_load(st, S, nu, np, lane);
            const LAS unsigned char* pb = wl + (pcount & 1) * R2_PIECE;
            auto step = [&](const int s4, const bool tail) __attribute__((always_inline)) {
                const int i = piece * 4 + s4;
                const LAS unsigned char* ps = pb + s4 * R2_STEP;
                const LAS f32x4* pa = (const LAS f32x4*)(ps + hf * 16);
                const LAS f32x4* pr = (const LAS f32x4*)rprev;
                const LAS unsigned char* ap0 = ps + 256 + hf * 768 + n * 8; const u32x4 A1p = r2_aop(aprev, adl); u32x4 A0; float vv;
                f32x2 sa[4], ya[4];
#pragma unroll
                for (int blk = 0; blk < 4; ++blk) { sa[blk] = (f32x2){0.f, 0.f}; ya[blk] = (f32x2){0.f, 0.f}; }
                f32x4 av = pa[0], rv = pr[0];
                __builtin_amdgcn_sched_barrier(0);
                if (!(VAR & 1)) {
                    X[0][1] = r2_mfma(A1p, Bt0, X[0][1]); X[1][1] = r2_mfma(A1p, Bt1, X[1][1]); X[2][1] = r2_mfma(A1p, Bt2, X[2][1]); X[3][1] = r2_mfma(A1p, Bt3, X[3][1]); }
#pragma unroll
                for (int g = 0; g < 8; ++g) { const int jb = g >> 2, q = g & 3;
                    f32x4 avn = av, rvn = rv; if (g < 7) { const int qi = 8 * ((g + 1) >> 2) + 2 * ((g + 1) & 3); avn = pa[qi]; rvn = pr[qi]; }
#pragma unroll
                    for (int h2 = 0; h2 < 2; ++h2) { const f32x2 a2 = h2 ? (f32x2){av.z, av.w} : (f32x2){av.x, av.y}, r2 = h2 ? (f32x2){rv.z, rv.w} : (f32x2){rv.x, rv.y};
#pragma unroll
                        for (int blk = 0; blk < 4; ++blk) { const f32x2 x = (f32x2){X[blk][jb][4 * q + 2 * h2], X[blk][jb][4 * q + 2 * h2 + 1]};
                            sa[blk] = x * a2 + sa[blk]; ya[blk] = x * r2 + ya[blk]; } }
                    if (g == 3) {
#pragma unroll
                        for (int k = 0; k < 4; ++k) { __builtin_amdgcn_sched_group_barrier(0x008, 1, 0); __builtin_amdgcn_sched_group_barrier(0x002, 16, 0); }
                        __builtin_amdgcn_sched_barrier(0); }
                    if (g == 5) { __builtin_amdgcn_sched_barrier(0); A0 = r2_aop(ap0, adl); vv = *(const LAS float*)(ps + 1536 + ln * 4); }
                    av = avn; rv = rvn; }
                float sh0 = sa[0].x + sa[0].y, sh1 = sa[1].x + sa[1].y, sz0 = sa[2].x + sa[2].y, sz1 = sa[3].x + sa[3].y;
                swap32(sh0, sh1); swap32(sz0, sz1);
                float hA = sh0 + sh1, hB = 0.f, zA = sz0 + sz1, zB = vv;
                swap32(hA, hB); swap32(zA, zB);
                { const u32x2 b0 = r2_hilo_b(hA), b1 = r2_hilo_b(hB), b2 = r2_hilo_b(zA), b3 = r2_hilo_b(zB);
                  Bt0.x = b0.x; Bt0.y = b0.y; Bt1.x = b1.x; Bt1.y = b1.y; Bt2.x = b2.x; Bt2.y = b2.y; Bt3.x = b3.x; Bt3.y = b3.y; }
                if (!(VAR & 3)) {
                    X[0][0] = r2_mfma(A0, Bt0, X[0][0]); X[1][0] = r2_mfma(A0, Bt1, X[1][0]); X[2][0] = r2_mfma(A0, Bt2, X[2][0]); X[3][0] = r2_mfma(A0, Bt3, X[3][0]); }
                float q0 = ya[0].x + ya[0].y, q1 = ya[1].x + ya[1].y, e0 = ya[2].x + ya[2].y, e1 = ya[3].x + ya[3].y;
                swap32(q0, q1); swap32(e0, e1);
                if (tail || i > 0) { *(_Float16*)((char*)QQ + (unsigned)(((unit * 64 + i - 1) * 64 + lane) * 2)) = (_Float16)(q0 + q1); *(float*)((char*)YR + (unsigned)(((c * 64 + i - 1) * RW + hh * 64 + lane) * 4)) = e0 + e1; }
                aprev = ap0 + 256;
                rprev = ps + hf * 16 + 768;
            };
#pragma unroll 1
            for (int s4 = 0; s4 < 3; ++s4) step(s4, false);
            step(3, true);
            r2_write(st, wl + ((pcount + 1) & 1) * R2_PIECE, cst, lane, np == 0, np == NP - 1 && !spare, np == 0 && nu < 16);
            asm volatile("s_waitcnt lgkmcnt(0)" ::: "memory");
        }
        { const u32x4 A1p = r2_aop(aprev, adl); X[0][1] = r2_mfma(A1p, Bt0, X[0][1]); X[1][1] = r2_mfma(A1p, Bt1, X[1][1]); X[2][1] = r2_mfma(A1p, Bt2, X[2][1]); X[3][1] = r2_mfma(A1p, Bt3, X[3][1]); }
        { const LAS f32x4* pr = (const LAS f32x4*)rprev; const LAS f32x4* pw = (const LAS f32x4*)((const LAS unsigned char*)cst + 1280 + hf * 16);
            f32x2 ya[4];
#pragma unroll
            for (int blk = 0; blk < 4; ++blk) ya[blk] = (f32x2){0.f, 0.f};
#pragma unroll
            for (int g = 0; g < 8; ++g) { const int jb = g >> 2, q = g & 3; const f32x4 rv = pr[8 * jb + 2 * q];
                const f32x4 wv = pw[8 * jb + 2 * q];
#pragma unroll
                for (int blk = 0; blk < 4; ++blk) {
                    ya[blk] = (f32x2){X[blk][jb][4 * q], X[blk][jb][4 * q + 1]} * (f32x2){rv.x, rv.y} + ya[blk]; ya[blk] = (f32x2){X[blk][jb][4 * q + 2], X[blk][jb][4 * q + 3]} * (f32x2){rv.z, rv.w} + ya[blk];
#pragma unroll
                    for (int e = 0; e < 4; ++e) X[blk][jb][4 * q + e] *= wv[e]; } }
            float q0 = ya[0].x + ya[0].y, q1 = ya[1].x + ya[1].y, e0 = ya[2].x + ya[2].y, e1 = ya[3].x + ya[3].y;
            swap32(q0, q1); swap32(e0, e1);
            { QQ[((size_t)unit * 64 + 63) * 64 + lane] = (_Float16)(q0 + q1); YR[(size_t)(c * 64 + 63) * RW + hh * 64 + lane] = e0 + e1; } }
#pragma unroll
        for (int rs = 0; rs < 2; ++rs) { const int row = n + 32 * rs;
#pragma unroll
            for (int jb = 0; jb < 2; ++jb)
#pragma unroll
                for (int q = 0; q < 4; ++q) { const int col = 32 * jb + 8 * q + 4 * hf;
                    *(f32x4*)(LL + ((((size_t)unit * 4 + (row >> 4)) * 4 + (col >> 4)) * 64 + (row & 15) + 16 * ((col >> 2) & 3)) * 4) = (f32x4){X[2 + rs][jb][4 * q], X[2 + rs][jb][4 * q + 1], X[2 + rs][jb][4 * q + 2], X[2 + rs][jb][4 * q + 3]};
#pragma unroll
                    for (int e = 0; e < 4; ++e) { const int cl = col + e;
                        PT[((((size_t)unit * 4 + (cl >> 4)) * 2 + (row >> 5)) * 64 + (cl & 15) + 16 * ((row >> 2) & 3)) * 8 + ((row >> 4) & 1) * 4 + (row & 3)] = (bf16_t)f2bf(X[rs][jb][4 * q + e]); } }
        }
    }
}
template <int MODE>
__device__ __forceinline__ void chain_run(int hh, int grp, int w, int lane, LAS unsigned char* ring, const bf16_t* PT, const float* LL, bf16_t* PGF, float* LGF, float* GSF, float* SC) {
    constexpr int NS = 16, RD = 4, RS = 5, SLOT = 24576;
    const int vq = w & 3, fr = lane & 15, q4 = lane >> 4;
    const bf16_t* Asrc = (MODE == 1) ? PGF : PT; const float* Lsrc = (MODE == 1) ? LGF : LL;
#define CH_UNIT(s_) ((MODE == 1) ? (size_t)(hh * 16 + (s_)) : (size_t)((grp * 16 + (s_)) * RH + hh))
#define CH_ISSUE(s_) do { const int ss_ = (s_) < NS ? (s_) : NS - 1; const size_t u_ = CH_UNIT(ss_); LAS unsigned char* sl_ = ring + ((s_) % RS) * SLOT; \
        __builtin_amdgcn_global_load_lds((const unsigned*)(Asrc + (u_ * 8 + w) * 512 + lane * 8), (LAS unsigned*)(sl_ + w * 1024), 16, 0, 0); \
        __builtin_amdgcn_global_load_lds((const unsigned*)(Lsrc + (u_ * 16 + w) * 256 + lane * 4), (LAS unsigned*)(sl_ + (8 + w) * 1024), 16, 0, 0); \
        __builtin_amdgcn_global_load_lds((const unsigned*)(Lsrc + (u_ * 16 + 8 + w) * 256 + lane * 4), (LAS unsigned*)(sl_ + (16 + w) * 1024), 16, 0, 0); } while (0)
    CH_ISSUE(0); CH_ISSUE(1); CH_ISSUE(2); CH_ISSUE(3);
    f32x4 Xs[4];
    const bool prun = (MODE == 0) && (w >= 4);
    const bool comp = (MODE == 0) || (w < 4);
#pragma unroll
    for (int tn = 0; tn < 4; ++tn) { Xs[tn] = (f32x4){0.f, 0.f, 0.f, 0.f};
        if (MODE == 0) { if (prun) {
#pragma unroll
            for (int rg = 0; rg < 4; ++rg) Xs[tn][rg] = (16 * tn + 4 * q4 + rg == 16 * vq + fr) ? 1.f : 0.f; } }
        if (MODE == 2) { if (w < 4) Xs[tn] = *(const f32x4*)(GSF + (((size_t)(hh * 16 + grp) * 4 + vq) * 4 + tn) * 256 + lane * 4); } }
    asm volatile("s_waitcnt vmcnt(9)" ::: "memory"); __builtin_amdgcn_s_barrier();
    for (int st = 0; st < NS; ++st) {
        CH_ISSUE(st + RD);
        if (comp) {
            const LAS unsigned char* sl = ring + (st % RS) * SLOT;
            if (MODE == 1) { float* gp = GSF + (((size_t)(hh * 16 + st) * 4 + vq) * 4) * 256 + lane * 4;
#pragma unroll
                for (int tn = 0; tn < 4; ++tn) *(f32x4*)(gp + tn * 256) = Xs[tn]; }
            if (MODE == 2) { float* scp = SC + (((size_t)((grp * 16 + st) * RH + hh) * 4 + vq) * 4) * 256 + lane * 4;
#pragma unroll
                for (int tn = 0; tn < 4; ++tn) *(f32x4*)(scp + tn * 256) = Xs[tn]; }
            bf16x8 Bh[2], Bl[2];
#pragma unroll
            for (int s_ = 0; s_ < 2; ++s_) { unsigned hw[4], lw_[4];
#pragma unroll
                for (int e = 0; e < 4; ++e) { const f32x4 xv = Xs[2 * s_ + (e >> 1)]; const float x0 = xv[2 * (e & 1)], x1 = xv[2 * (e & 1) + 1];
                    const unsigned hp = cvtpk(x0, x1); hw[e] = hp; lw_[e] = cvtpk(x0 - bflo(hp), x1 - bfhi(hp)); }
                Bh[s_] = __builtin_bit_cast(bf16x8, (u32x4){hw[0], hw[1], hw[2], hw[3]}); Bl[s_] = __builtin_bit_cast(bf16x8, (u32x4){lw_[0], lw_[1], lw_[2], lw_[3]}); }
#pragma unroll
            for (int tm = 0; tm < 4; ++tm) { f32x4 acc = (f32x4){0.f, 0.f, 0.f, 0.f};
                if (!prun) acc = *(const LAS f32x4*)(sl + (8 + vq * 4 + tm) * 1024 + lane * 16);
#pragma unroll
                for (int s_ = 0; s_ < 2; ++s_) { const bf16x8 Af = *(const LAS bf16x8*)(sl + (tm * 2 + s_) * 1024 + lane * 16);
                    acc = __builtin_amdgcn_mfma_f32_16x16x32_bf16(Af, Bh[s_], acc, 0, 0, 0); acc = __builtin_amdgcn_mfma_f32_16x16x32_bf16(Af, Bl[s_], acc, 0, 0, 0); }
                Xs[tm] = acc; }
        }
        if (MODE != 0 && w < 4) asm volatile("s_waitcnt vmcnt(25) lgkmcnt(0)" ::: "memory"); else asm volatile("s_waitcnt vmcnt(9) lgkmcnt(0)" ::: "memory");
        __builtin_amdgcn_s_barrier();
    }
    asm volatile("s_waitcnt vmcnt(0)" ::: "memory");
    if (MODE == 0) {
        if (!prun) { float* lp = LGF + (((size_t)(hh * 16 + grp) * 4 + vq) * 4) * 256 + lane * 4;
#pragma unroll
            for (int tn = 0; tn < 4; ++tn) *(f32x4*)(lp + tn * 256) = Xs[tn]; }
        else { bf16_t* pp = PGF + (size_t)(hh * 16 + grp) * 4096;
#pragma unroll
            for (int tn = 0; tn < 4; ++tn)
#pragma unroll
                for (int rg = 0; rg < 4; ++rg) pp[(((tn * 2 + (vq >> 1)) * 64) + (4 * q4 + rg) + 16 * ((fr >> 2) & 3)) * 8 + (vq & 1) * 4 + (fr & 3)] = (bf16_t)f2bf(Xs[tn][rg]); }
    }
#undef CH_UNIT
#undef CH_ISSUE
}
struct TItem { const float* W; int ldw, k0, n0; bf16_t* WT; size_t ldt; int drow0; const float* ks; };
__device__ __forceinline__ void t64_load(const TItem& t, f32x4 (&ra)[8], f32x4 (&rb)[8], int lane) {
    const int kr = lane >> 4, c4 = lane & 15;
#pragma unroll
    for (int i = 0; i < 8; ++i) { const float* p = t.W + (size_t)(t.k0 + 8 * i + 2 * kr) * t.ldw + t.n0 + 4 * c4; ra[i] = __builtin_nontemporal_load((const f32x4*)p); rb[i] = __builtin_nontemporal_load((const f32x4*)(p + t.ldw)); }
}
__device__ __forceinline__ void t64_finish(const TItem& t, const f32x4 (&ra)[8], const f32x4 (&rb)[8], LAS unsigned* scr, int lane) {
    const int kr = lane >> 4, c4 = lane & 15;
#pragma unroll
    for (int i = 0; i < 8; ++i) { float s0 = 1.f, s1 = 1.f; if (t.ks) { const f32x2 sv = *(const f32x2*)(t.ks + t.k0 + 8 * i + 2 * kr); s0 = sv.x; s1 = sv.y; }
#pragma unroll
        for (int e = 0; e < 4; ++e) { const int n = 4 * c4 + e; scr[n * 32 + ((4 * i + kr) ^ (4 * (c4 & 7)))] = cvtpk(ra[i][e] * s0, rb[i][e] * s1); } }
    LDS_WAIT(); asm volatile("" ::: "memory");
#pragma unroll
    for (int j = 0; j < 8; ++j) { const int id = lane + 64 * j, n = id >> 3, ch = id & 7;
        const u32x4 v = *(const LAS u32x4*)(scr + n * 32 + ((ch ^ ((n >> 2) & 7)) << 2));
        __builtin_nontemporal_store(v, (u32x4*)(t.WT + (size_t)(t.drow0 + n) * t.ldt + t.k0 + ch * 8)); }
    LDS_WAIT(); asm volatile("" ::: "memory");
}
constexpr int CONV_EARLY = 16 * 256;
constexpr int CONV_RT = 64 * 768 - 10240;
constexpr int CONV_SPLIT = CONV_EARLY + 32 * 768 - 2048;
__device__ __forceinline__ void expert_conv_item(int it, const float* weg, const float* weu, const float* wed, bf16_t* wgu_e, bf16_t* wd_e, LAS unsigned* scr64, int lane, const float* gffn_) {
    constexpr int C_G = (DM / 64) * (DE / 64);
    const int e = it / (3 * C_G); int r = it % (3 * C_G);
    if (r < 2 * C_G) { const int up = r >= C_G; if (up) r -= C_G; const int nblk = DE / 64, kb = r / nblk, nb = r % nblk, n0 = 64 * nb;
        transpose64_item((up ? weu : weg) + (size_t)e * DM * DE, DE, 64 * kb, n0, wgu_e, (size_t)DM, (n0 >> 7) * 256 + up * 128 + (n0 & 127), gffn_, scr64, lane); }
    else { r -= 2 * C_G; transpose64_mat_item(wed + (size_t)e * DE * DM, DE, DM, wd_e, nullptr, r, scr64, lane); }
}
__device__ __forceinline__ TItem expert_item(int it, const float* weg, const float* weu, const float* wed, GAS unsigned char* wsl, const float* gffn) {
    constexpr int C_G = (DM / 64) * (DE / 64);
    int e, r;
    if (it < CONV_EARLY) { e = 48 + it / C_G; r = 2 * C_G + it % C_G; }
    else { const int j = it - CONV_EARLY; if (j < 48 * 3 * C_G) { e = j / (3 * C_G); r = j % (3 * C_G); } else { const int q = j - 48 * 3 * C_G; e = 48 + q / (2 * C_G); r = q % (2 * C_G); } }
    TItem t;
    bf16_t* wgu_e = (bf16_t*)(wsl + (e < WGU_SPLIT ? WS_WGU_A + (size_t)e * (4 * MiB) : WS_WGU_B + (size_t)(e - WGU_SPLIT) * (4 * MiB))); bf16_t* wd_e = (bf16_t*)(wsl + WS_WD + (size_t)e * (2 * MiB));
    if (r < 2 * C_G) { const int up = r >= C_G; if (up) r -= C_G; const int nblk = DE / 64, kb = r / nblk, nb = r % nblk, n0 = 64 * nb;
        t.W = (up ? weu : weg) + (size_t)e * DM * DE; t.ldw = DE; t.k0 = 64 * kb; t.n0 = n0; t.WT = wgu_e; t.ldt = DM; t.drow0 = (n0 >> 7) * 256 + up * 128 + (n0 & 127); t.ks = gffn; }
    else { r -= 2 * C_G; const int nblk = DM / 64, kb = r / nblk, nb = r % nblk;
        t.W = wed + (size_t)e * DE * DM; t.ldw = DM; t.k0 = 64 * kb; t.n0 = 64 * nb; t.WT = wd_e; t.ldt = DE; t.drow0 = 64 * nb; t.ks = nullptr; }
    return t;
}
__device__ __forceinline__ void expert_conv_stream(int it0, int end, int stride, const float* weg, const float* weu, const float* wed, GAS unsigned char* wsl, LAS unsigned* scr64, int lane, const float* gffn) {
    if (it0 >= end) return;
    f32x4 a0[8], b0[8], a1[8], b1[8];
    TItem c0 = expert_item(it0, weg, weu, wed, wsl, gffn); t64_load(c0, a0, b0, lane);
    for (int it = it0; it < end; it += 2 * stride) {
        const int i1 = it + stride, i2 = it + 2 * stride;
        TItem c1 = c0; if (i1 < end) { c1 = expert_item(i1, weg, weu, wed, wsl, gffn); t64_load(c1, a1, b1, lane); }
        t64_finish(c0, a0, b0, scr64, lane);
        if (i1 < end) { if (i2 < end) { c0 = expert_item(i2, weg, weu, wed, wsl, gffn); t64_load(c0, a0, b0, lane); }
            t64_finish(c1, a1, b1, scr64, lane); }
    }
}
enum { PH_PRO = 0, PH_G1, PH_E1, PH_G2, PH_QKF, PH_ATT, PH_R2, PH_R3, PH_R3B, PH_R3C, PH_R4, PH_RO, PH_BR, PH_OUT, PH_E3, PH_RT, PH_SCAT, PH_GU, PH_DN, PH_E4, PH_PLE, N_PHASES };
__global__ void __launch_bounds__(NWAVES * 64, 2) mega(Args args) {
    extern __shared__ __attribute__((aligned(16))) unsigned char lds_raw[];
    Frame F; F.lds = (LAS unsigned char*)lds_raw; F.tid = threadIdx.x; F.lane = F.tid & 63; F.wave = __builtin_amdgcn_readfirstlane(F.tid >> 6);
    F.G = gridDim.x; F.gw = blockIdx.x * NWAVES + F.wave; F.NGW = F.G * NWAVES; F.ws = args.ws;
    unsigned char* ws = args.ws;
    gu32* ctl = (gu32*)(ws + WS_CTL);
    volatile LAS unsigned* MISC = (volatile LAS unsigned*)(F.lds + MISC_OFF);
    if (F.tid < 64) MISC[F.tid] = 0u;
    __syncthreads();
#if MK_ONE_LAUNCH
    XcdBarrier bar = xcd_barrier_post((unsigned*)ctl + CW_BAR + args.li * XCD_BAR_WORDS, MISC + 8);
#define GRID_BAR() xcd_barrier(bar)
#else
#define GRID_BAR() do {} while (0)
#endif
    const int lo = args.ph_lo, hi = args.ph_hi;
#ifndef PHASE_MASK
#define PHASE_MASK 0xFFFFFFFFu
#endif
#define IN(k) (((PHASE_MASK >> (k)) & 1u) && lo <= (k) && (k) < hi)
#ifndef PROBE_PH
#define PROBE_PH -1
#endif
#ifndef PROBE_N
#define PROBE_N 2
#endif
#define PHASE(k) if (IN(k))
#define SEAM(k) do { if (IN(k) && IN((k) + 1)) GRID_BAR(); } while (0)
    const int lane = F.lane, gw = F.gw, NGW = F.NGW;
#define WIN ((bf16_t*)(wsl + WS_WIN))
#define WQB ((bf16_t*)(wsl + WS_WQB))
#define WKVB ((bf16_t*)(wsl + WS_WKVB))
#define W2T ((bf16_t*)(wsl + WS_W2T))
#define A2T ((bf16_t*)(wsl + WS_A2T))
#define G2T ((bf16_t*)(wsl + WS_G2T))
#define WBR ((bf16_t*)(wsl + WS_WBR))
#define WOUT ((bf16_t*)(wsl + WS_WOUT))
#define WRT ((bf16_t*)(wsl + WS_WRT))
#define WPG ((bf16_t*)(wsl + WS_WPG))
#define WPP ((bf16_t*)(wsl + WS_WPP))
#define HB ((bf16_t*)(wsl + WS_HB))
#define PB ((bf16_t*)(wsl + WS_PB))
#define TAB ((float*)(wsl + WS_TAB))
#define PROJ ((bf16_t*)(wsl + WS_PROJ))
#define QB_ ((bf16_t*)(wsl + WS_Q))
#define KVB ((bf16_t*)(wsl + WS_KV))
#define K2B ((bf16_t*)(wsl + WS_KR))
#define OA ((bf16_t*)(wsl + WS_OA))
#define OB ((bf16_t*)(wsl + WS_OB))
#define LW ((float*)(wsl + WS_LW))
#define AA ((bf16_t*)(wsl + WS_AA))
#define GG ((bf16_t*)(wsl + WS_GG))
#define TW ((bf16_t*)(wsl + WS_TW))
#define ZA ((bf16_t*)(wsl + WS_ZA))
#define SG ((bf16_t*)(wsl + WS_SG))
#define MERGED ((bf16_t*)(wsl + WS_MERGED))
#define YR ((float*)(wsl + WS_YR))
#define WGU_E(e) ((bf16_t*)(wsl + ((e) < WGU_SPLIT ? WS_WGU_A + (size_t)(e) * (4 * MiB) : WS_WGU_B + (size_t)((e) - WGU_SPLIT) * (4 * MiB))))
#define WD_E(e) ((bf16_t*)(wsl + WS_WD + (size_t)(e) * (2 * MiB)))
#define RSTD2 ((float*)(wsl + WS_SMALL + SM_RSTD2))
#define ACT ((bf16_t*)(wsl + WS_ACT))
#define YB ((bf16_t*)(wsl + WS_Y))
#define LOGITS ((float*)(wsl + WS_LOGITS))
#define PLEB ((bf16_t*)(wsl + WS_PLE))
#define RSTDQ ((float*)(wsl + WS_SMALL + SM_RSTDQ))
#define RSTDKV ((float*)(wsl + WS_SMALL + SM_RSTDKV))
#define RSTDPLE ((float*)(wsl + WS_SMALL + SM_RSTDPLE))
#define TOKE ((int*)(wsl + WS_SMALL + SM_TOKE))
#define TOKP ((int*)(wsl + WS_SMALL + SM_TOKP))
#define TOKW ((float*)(wsl + WS_SMALL + SM_TOKW))
#define ROWTOK ((int*)(wsl + WS_SMALL + SM_ROWTOK))
#define X1B ((bf16_t*)(wsl + WS_X1B))
#define SSQP ((float*)(wsl + WS_CTL) + 81920)
#define SSQ1 ((float*)(wsl + WS_CTL) + 65536)
#define X2B ((bf16_t*)(wsl + WS_X2B))
#define CNT ((unsigned*)((gu32*)(wsl + WS_CTL)) + CW_CNT)
    GAS unsigned char* wsl = (GAS unsigned char*)args.ws;
    const float* X = args.in[I_X]; float* OUT = args.out;
    LAS float* scr = (LAS float*)(F.lds + F.wave * 16384);

    PHASE(PH_PRO) { GAS unsigned char* wsl = (GAS unsigned char*)args.ws; asm volatile("" : "+s"(wsl)); int lane_l = F.tid & 63; asm volatile("" : "+v"(lane_l)); const int lane = lane_l;
        constexpr int C_IN = (DM / 64) * (IN_TOTAL / 64);
        LAS unsigned* scr64 = (LAS unsigned*)scr;
        for (int it = gw; it < C_IN; it += NGW) transpose64_mat_item(args.in[I_WIN], DM, IN_TOTAL, WIN, nullptr, it, scr64, lane);
        for (int m = gw; m < T; m += 2 * NGW) norm_row2_bf16(X + (size_t)m * DM, X + (size_t)(m + NGW) * DM, args.in[I_GMIX], HB + (size_t)m * DM, HB + (size_t)(m + NGW) * DM, lane);
    }
    SEAM(PH_PRO);
    PHASE(PH_G1) { GAS unsigned char* wsl = (GAS unsigned char*)args.ws; asm volatile("" : "+s"(wsl)); int lane_l = F.tid & 63; asm volatile("" : "+v"(lane_l)); const int lane = lane_l;
        { pg8::Gemm g{HB, WIN, DM, DM, DM, nullptr}; pg8::StaticOrder S; S.init(T, IN_TOTAL, F.G, (int)blockIdx.x);
          pg8::EpiBf16 E{PROJ, IN_TOTAL, nullptr};
          pg8::gemm_phase<pg8::EpiBf16, pg8::StaticOrder, false>(F.lds, g, S, E); }
        __syncthreads();
        const int nwg_ = (T / 256) * (IN_TOTAL / 256), short0 = nwg_ % F.G;
        const int li = (short0 == 0) ? (int)blockIdx.x : (int)blockIdx.x - short0, nl = (short0 == 0) ? F.G : F.G - short0;
        if (li >= 0) {
            constexpr int C_QB = (QL / 64) * (1536 / 64), C_KVB = (KVL / 64) * (2048 / 64), C_W2 = 2 * (RW / 32), C_G2 = (GLORA / 64) * (RW / 64);
            constexpr int C_BR = (1024 / 64) * (DM / 64), C_SQ = (DM / 64) * (DM / 64), C_PP = (PLE / 64) * (DM / 64), C_EX = (DM / 64) * (NE / 64);
            constexpr int NIT = C_QB + C_KVB + 2 * C_W2 + C_G2 + 2 * C_BR + 2 * C_SQ + C_PP + C_EX;
            LAS unsigned* scr64 = (LAS unsigned*)scr;
            const int lw_ = li * NWAVES + F.wave, nlw = nl * NWAVES, lt = li * 512 + F.tid, nlt = nl * 512;
            for (int it = lw_; it < NIT; it += nlw) {
                int r = it;
                if (r < C_QB) { transpose64_mat_item(args.in[I_WQB], QL, 1536, WQB, args.in[I_GQA], r, scr64, lane); continue; } r -= C_QB;
                if (r < C_KVB) { transpose64_mat_item(args.in[I_WKVB], KVL, 2048, WKVB, args.in[I_GKVA], r, scr64, lane); continue; } r -= C_KVB;
                if (r < C_W2) { transpose_mat_item(args.in[I_W2], DLORA, 128, RW, W2T, nullptr, r, scr, lane); continue; } r -= C_W2;
                if (r < C_W2) { transpose_mat_item(args.in[I_A2], ALORA, 128, RW, A2T, nullptr, r, scr, lane); continue; } r -= C_W2;
                if (r < C_G2) { transpose64_mat_item(args.in[I_G2], GLORA, RW, G2T, nullptr, r, scr64, lane); continue; } r -= C_G2;
                if (r < C_BR) { transpose64_mat_item(args.in[I_WBR], 1024, DM, WBR, nullptr, r, scr64, lane); continue; } r -= C_BR;
                if (r < C_BR) { transpose64_mat_item(args.in[I_WBR] + (size_t)1024 * DM, 1024, DM, WBR + (size_t)DM * 1024, nullptr, r, scr64, lane); continue; } r -= C_BR;
                if (r < C_SQ) { transpose64_mat_item(args.in[I_WOUT], DM, DM, WOUT, nullptr, r, scr64, lane); continue; } r -= C_SQ;
                if (r < C_SQ) { transpose64_mat_item(args.in[I_WPG], DM, DM, WPG, args.in[I_GPLE], r, scr64, lane); continue; } r -= C_SQ;
                if (r < C_PP) { transpose64_mat_item(args.in[I_WPP], PLE, DM, WPP, nullptr, r, scr64, lane); continue; } r -= C_PP;
                transpose64_item(args.in[I_WEXP], NE, 64 * r, 0, WRT, (size_t)DM, 8, args.in[I_GFFN], scr64, lane);
            }
            for (int i = lt; i < NROUTE * DM; i += nlt) { const int n = i / DM, k = i % DM;
                if (n < NG) WRT[i] = (bf16_t)f2bf(args.in[I_WGRP][(size_t)k * NG + n] * args.in[I_GFFN][k]); else if (n >= NG + NE) WRT[i] = 0; }
            for (int i = lt; i < T * PLE / 4; i += nlt) { const f32x4 v = ((const f32x4*)args.in[I_P])[i]; u32x2 w; w.x = cvtpk(v.x, v.y); w.y = cvtpk(v.z, v.w); ((u32x2*)PB)[i] = w; }
            for (int i = lt; i < T * 32; i += nlt) { const int t = i >> 5, j = i & 31;
                const float a = (float)((const int*)args.in[I_POS])[t] * args.inv_freq[j];
                const double rev = (double)a * 0.15915494309189535; const float fr = (float)(rev - rint(rev));
                TAB[(size_t)t * 64 + j] = __builtin_amdgcn_cosf(fr); TAB[(size_t)t * 64 + 32 + j] = __builtin_amdgcn_sinf(fr); }
            expert_conv_stream(lw_, CONV_EARLY, nlw, args.in[I_WEG], args.in[I_WEU], args.in[I_WED], wsl, scr64, lane, args.in[I_GFFN]);
        }
    }
    SEAM(PH_G1);
    PHASE(PH_E1) { GAS unsigned char* wsl = (GAS unsigned char*)args.ws; asm volatile("" : "+s"(wsl)); int lane_l = F.tid & 63; asm volatile("" : "+v"(lane_l)); const int lane = lane_l;
        const float* mu = args.in[I_MU];
        for (int t = gw; t < T; t += NGW) {
            const bf16_t* row = PROJ + (size_t)t * IN_TOTAL;
            float f[8]; unpack8(*(const u32x4*)(row + lane * 8), f); float s = 0.f;
#pragma unroll
            for (int j = 0; j < 8; ++j) s += f[j] * f[j];
            s = wave_sum(s); if (lane == 0) RSTDQ[t] = rsqrtf(s * (1.f / QL) + EPS);
            unpack8(*(const u32x4*)(row + QL + lane * 8), f); s = 0.f;
#pragma unroll
            for (int j = 0; j < 8; ++j) s += f[j] * f[j];
            s = wave_sum(s); if (lane == 0) RSTDKV[t] = rsqrtf(s * (1.f / KVL) + EPS);
            if (lane < 56) {
                const int e0 = lane * 8; float z[8], zp[8], o[8];
                unpack8(*(const u32x4*)(row + MLA_IN + 3 * RW + e0), z);
                if (t > 0) unpack8(*(const u32x4*)(row - IN_TOTAL + MLA_IN + 3 * RW + e0), zp); else {
#pragma unroll
                    for (int j = 0; j < 8; ++j) zp[j] = 0.f; }
#pragma unroll
                for (int j = 0; j < 8; ++j) { const float m = z[j] + (zp[j] - z[j]) * mu[3 * RW + e0 + j]; o[j] = lane < 12 ? tanhf(m) : (lane < 24 ? m : sigmoidf_(m)); }
                u32x4 w; w.x = cvtpk(o[0], o[1]); w.y = cvtpk(o[2], o[3]); w.z = cvtpk(o[4], o[5]); w.w = cvtpk(o[6], o[7]);
                if (lane < 12) *(u32x4*)(TW + (size_t)t * 128 + e0) = w; else if (lane < 24) *(u32x4*)(ZA + (size_t)t * 128 + (e0 - 96)) = w; else *(u32x4*)(SG + (size_t)t * 256 + (e0 - 192)) = w;
            } else { const u32x4 z = {0u, 0u, 0u, 0u};
                if (lane < 60) *(u32x4*)(TW + (size_t)t * 128 + 96 + (lane - 56) * 8) = z; else *(u32x4*)(ZA + (size_t)t * 128 + 96 + (lane - 60) * 8) = z; }
        }
    }
    SEAM(PH_E1);
    PHASE(PH_G2) { GAS unsigned char* wsl = (GAS unsigned char*)args.ws; asm volatile("" : "+s"(wsl));
        { pg8::Gemm g{PROJ, WQB, IN_TOTAL, QL, QL, nullptr}; pg8::StaticOrder S; S.init(T, 1536, F.G, (int)blockIdx.x); pg8::EpiBf16 E{QB_, 1536, RSTDQ};
          pg8::gemm_phase<pg8::EpiBf16, pg8::StaticOrder, false>(F.lds, g, S, E); }
        { pg8::Gemm g{PROJ + QL, WKVB, IN_TOTAL, KVL, KVL, nullptr}; pg8::StaticOrder S; S.init(T, 2048, F.G, (int)blockIdx.x); pg8::EpiBf16 E{KVB, 2048, RSTDKV};
          pg8::gemm_phase<pg8::EpiBf16, pg8::StaticOrder, false>(F.lds, g, S, E); }
        { pg8::Gemm g{TW, W2T, 128, 128, 128, nullptr}; pg8::StaticOrder S; S.init(T, RW, F.G, (int)blockIdx.x); pg8::EpiLogW E{LW, args.in[I_W0]};
          pg8::gemm_phase<pg8::EpiLogW, pg8::StaticOrder, false>(F.lds, g, S, E); }
        { pg8::Gemm g{ZA, A2T, 128, 128, 128, nullptr}; pg8::StaticOrder S; S.init(T, RW, F.G, (int)blockIdx.x); pg8::EpiSigBias E{AA, args.in[I_A0]};
          pg8::gemm_phase<pg8::EpiSigBias, pg8::StaticOrder, false>(F.lds, g, S, E); }
        { pg8::Gemm g{SG, G2T, 256, 256, 256, nullptr}; pg8::StaticOrder S; S.init(T, RW, F.G, (int)blockIdx.x); pg8::EpiBf16 E{GG, RW, nullptr};
          pg8::gemm_phase<pg8::EpiBf16, pg8::StaticOrder, false>(F.lds, g, S, E); }
    }
    SEAM(PH_G2);
    PHASE(PH_QKF) { GAS unsigned char* wsl = (GAS unsigned char*)args.ws; asm volatile("" : "+s"(wsl)); int lane_l = F.tid & 63; asm volatile("" : "+v"(lane_l)); const int lane = lane_l;
        const float* gk = args.in[I_GKH];
        const int hh = lane >> 3, sub = lane & 7, jr = sub & 3;
        float gk0[8], gk1[8], gk2[8];
#pragma unroll
        for (int j = 0; j < 8; ++j) { gk0[j] = gk[sub * 8 + j]; gk1[j] = gk[64 + sub * 8 + j]; gk2[j] = gk[128 + sub * 8 + j]; }
        for (int t = gw; t < T; t += NGW) {
            const bf16_t* kp = KVB + (size_t)t * 2048 + hh * 256 + sub * 8;
            const u32x4 k0w = *(const u32x4*)kp, k1w = *(const u32x4*)(kp + 64), k2w = *(const u32x4*)(PROJ + (size_t)t * IN_TOTAL + QL + KVL + sub * 8);
            const float* tab = TAB + (size_t)t * 64 + jr * 8; float cs[8], sn[8];
#pragma unroll
            for (int q = 0; q < 2; ++q) { const f32x4 c4 = *(const f32x4*)(tab + 4 * q), s4 = *(const f32x4*)(tab + 32 + 4 * q); cs[4 * q] = c4.x; cs[4 * q + 1] = c4.y; cs[4 * q + 2] = c4.z; cs[4 * q + 3] = c4.w; sn[4 * q] = s4.x; sn[4 * q + 1] = s4.y; sn[4 * q + 2] = s4.z; sn[4 * q + 3] = s4.w; }
            float k0[8], k1[8], k2[8];
            unpack8(k0w, k0); unpack8(k1w, k1); unpack8(k2w, k2);
            float sk = 0.f;
#pragma unroll
            for (int j = 0; j < 8; ++j) sk += k0[j] * k0[j] + k1[j] * k1[j] + k2[j] * k2[j];
            sk += __shfl_xor(sk, 1); sk += __shfl_xor(sk, 2); sk += __shfl_xor(sk, 4);
            const float rk = rsqrtf(sk * (1.f / QKD) + EPS);
            float ok2[8];
#pragma unroll
            for (int j = 0; j < 8; ++j) { k0[j] *= rk * gk0[j]; k1[j] *= rk * gk1[j]; k2[j] *= rk * gk2[j]; }
#pragma unroll
            for (int j = 0; j < 8; ++j) { const float ko = __shfl_xor(k2[j], 4); ok2[j] = (sub < 4) ? k2[j] * cs[j] - ko * sn[j] : k2[j] * cs[j] + ko * sn[j]; }
            u32x4 w; bf16_t* ko_ = K2B + (size_t)t * 1536 + hh * QKD + sub * 8;
            w.x = cvtpk(k0[0], k0[1]); w.y = cvtpk(k0[2], k0[3]); w.z = cvtpk(k0[4], k0[5]); w.w = cvtpk(k0[6], k0[7]); *(u32x4*)ko_ = w;
            w.x = cvtpk(k1[0], k1[1]); w.y = cvtpk(k1[2], k1[3]); w.z = cvtpk(k1[4], k1[5]); w.w = cvtpk(k1[6], k1[7]); *(u32x4*)(ko_ + 64) = w;
            w.x = cvtpk(ok2[0], ok2[1]); w.y = cvtpk(ok2[2], ok2[3]); w.z = cvtpk(ok2[4], ok2[5]); w.w = cvtpk(ok2[6], ok2[7]); *(u32x4*)(ko_ + 128) = w;
        }
    }
    SEAM(PH_QKF);
    PHASE(PH_ATT) { GAS unsigned char* wsl = (GAS unsigned char*)args.ws; asm volatile("" : "+s"(wsl));
        if (F.wave >= 4) __builtin_amdgcn_s_setprio(1);
        for (int L = blockIdx.x; L < 256; L += F.G) { const int h = L & 7, x = L >> 3;
            for (int pass = 0; pass < 2; ++pass) att::attn_unit(h, pass ? x : 63 - x, QB_, K2B, KVB, OA, (LAS char*)F.lds, args.in[I_GQH], TAB); }
        __builtin_amdgcn_s_setprio(0);
    }
    SEAM(PH_ATT);
    #define PRM ((_Float16*)(wsl + WS_Q))
#define VM ((bf16_t*)(wsl + WS_OB))
#define PT ((bf16_t*)(wsl + WS_PT))
#define LL ((float*)(wsl + WS_HB))
#define QQ ((_Float16*)(wsl + WS_OB))
#define SC ((float*)(wsl + WS_MERGED))
    typedef _Float16 h2_t __attribute__((ext_vector_type(2)));
#define H2F(w_, hi_) ((float)__builtin_bit_cast(h2_t, (unsigned)(w_))[hi_])
#define FMIX(a_, spk_, hi_, c_) ((hi_) ? fmix_hi(a_, spk_, c_) : fmix_lo(a_, spk_, c_))
    PHASE(PH_R2) { GAS unsigned char* wsl = (GAS unsigned char*)args.ws; asm volatile("" : "+s"(wsl)); int lane_l = F.tid & 63; asm volatile("" : "+v"(lane_l)); const int lane = lane_l;
        asm volatile("s_waitcnt vmcnt(0) lgkmcnt(0)" ::: "memory"); __syncthreads();
        { const R2Src S2{PROJ, AA, LW};
#ifdef PROBE_VAR
          if (args.li == 1) r2_wave<PROBE_VAR>(gw, NGW, lane, F.lds + F.wave * R2_WAVE_LDS, S2, args.in[I_MU], args.in[I_KK], args.in[I_KA], YR, QQ, PT, LL); else
#endif
          r2_wave<0>(gw, NGW, lane, F.lds + F.wave * R2_WAVE_LDS, S2, args.in[I_MU], args.in[I_KK], args.in[I_KA], YR, QQ, PT, LL); }
    }
    SEAM(PH_R2);
#define PGF ((bf16_t*)(wsl + WS_TW))
#define LGF ((float*)(wsl + WS_TW + 2 * MiB))
#define GSF ((float*)(wsl + WS_TW + 6 * MiB))
#define R3_PHASE(MODE) do { GAS unsigned char* wsl = (GAS unsigned char*)args.ws; asm volatile("" : "+s"(wsl)); int lane_l = F.tid & 63; asm volatile("" : "+v"(lane_l)); const int lane = lane_l; \
        const int nwg_ = (MODE) == 1 ? RH : RH * 16; \
        if ((int)blockIdx.x < nwg_) { chain_run<MODE>((MODE) == 1 ? (int)blockIdx.x : ((int)blockIdx.x & 15), (MODE) == 1 ? 0 : ((int)blockIdx.x >> 4), F.wave, lane, F.lds, PT, LL, PGF, LGF, GSF, SC); } \
        __syncthreads(); } while (0)
    PHASE(PH_R3) { R3_PHASE(0); }
    SEAM(PH_R3);
    PHASE(PH_R3B) { R3_PHASE(1); }
    SEAM(PH_R3B);
    PHASE(PH_R3C) { R3_PHASE(2); }
    SEAM(PH_R3C);
#undef R3_PHASE

    PHASE(PH_R4) { GAS unsigned char* wsl = (GAS unsigned char*)args.ws; asm volatile("" : "+s"(wsl)); int lane_l = F.tid & 63; asm volatile("" : "+v"(lane_l)); const int lane = lane_l;
        typedef _Float16 f16x8 __attribute__((ext_vector_type(8))); typedef _Float16 f16x2 __attribute__((ext_vector_type(2)));
        constexpr int NU = (T / 64) * RH;
        const int n31 = lane & 31, kg = lane >> 5;
        LAS float* yl = (LAS float*)(F.lds + F.wave * 16384);
        const float* mu = args.in[I_MU];
        bf16_t* OB2 = (bf16_t*)(wsl + WS_HB);
        for (int unit = gw; unit < NU; unit += NGW) {
            const int c = unit >> 4, hh = unit & 15;
            float* yb = YR + (size_t)(c * 64 + 4 * kg) * RW + hh * 64 + n31;
            f32x16 acc[2][2];
#pragma unroll
            for (int tr = 0; tr < 2; ++tr)
#pragma unroll
                for (int tc = 0; tc < 2; ++tc)
#pragma unroll
                    for (int v = 0; v < 16; ++v) acc[tr][tc][v] = yb[(size_t)(32 * tr + 8 * (v >> 2) + (v & 3)) * RW + 32 * tc];
            f16x8 Bh[2][4], Bl[2][4];
#pragma unroll
            for (int tc = 0; tc < 2; ++tc) { const int ch = n31 + 32 * tc;
#pragma unroll
                for (int ks = 0; ks < 4; ++ks) {
                    const float* p = SC + ((((size_t)unit * 4 + (ch >> 4)) * 4 + ks) * 256) + ((ch & 15) + 32 * kg) * 4;
                    const f32x4 s0 = *(const f32x4*)p, s1 = *(const f32x4*)(p + 64);
                    const float sv[8] = {s0.x, s0.y, s0.z, s0.w, s1.x, s1.y, s1.z, s1.w};
                    f16x8 h, l;
#pragma unroll
                    for (int e = 0; e < 8; e += 2) { const f16x2 hp = __builtin_bit_cast(f16x2, __builtin_amdgcn_cvt_pkrtz(sv[e], sv[e + 1]));
                        const f16x2 lp = __builtin_bit_cast(f16x2, __builtin_amdgcn_cvt_pkrtz(sv[e] - (float)hp[0], sv[e + 1] - (float)hp[1]));
                        h[e] = hp[0]; h[e + 1] = hp[1]; l[e] = lp[0]; l[e + 1] = lp[1]; }
                    Bh[tc][ks] = h; Bl[tc][ks] = l; } }
#pragma unroll
            for (int tr = 0; tr < 2; ++tr)
#pragma unroll
                for (int ks = 0; ks < 4; ++ks) { const f16x8 A = *(const f16x8*)(QQ + (size_t)unit * 4096 + (n31 + 32 * tr) * 64 + 16 * ks + 8 * kg);
#pragma unroll
                    for (int tc = 0; tc < 2; ++tc) { acc[tr][tc] = __builtin_amdgcn_mfma_f32_32x32x16_f16(A, Bh[tc][ks], acc[tr][tc], 0, 0, 0); acc[tr][tc] = __builtin_amdgcn_mfma_f32_32x32x16_f16(A, Bl[tc][ks], acc[tr][tc], 0, 0, 0); } }
#pragma unroll
            for (int tr = 0; tr < 2; ++tr) {
#pragma unroll
                for (int tc = 0; tc < 2; ++tc)
#pragma unroll
                    for (int v = 0; v < 16; ++v) yl[(8 * (v >> 2) + 4 * kg + (v & 3)) * 68 + 32 * tc + n31] = (tr == 0) ? acc[0][tc][v] : acc[1][tc][v];
                const int t = c * 64 + 32 * tr + n31, e0 = hh * 64 + 32 * kg;
                const bf16_t* row = PROJ + (size_t)t * IN_TOTAL + MLA_IN + e0; const bf16_t* prow = (t > 0) ? row - IN_TOTAL : row; const bool tz = (t == 0);
                float y[32]; float s1 = 0.f, sb = 0.f;
#pragma unroll
                for (int q = 0; q < 4; ++q) { const int eq = e0 + 8 * q; float z[8], zp[8], av[8], cm[8], ck[8];
                    { const f32x4 y0 = *(const LAS f32x4*)(yl + n31 * 68 + 32 * kg + 8 * q), y1 = *(const LAS f32x4*)(yl + n31 * 68 + 32 * kg + 8 * q + 4);
                      y[8 * q] = y0.x; y[8 * q + 1] = y0.y; y[8 * q + 2] = y0.z; y[8 * q + 3] = y0.w; y[8 * q + 4] = y1.x; y[8 * q + 5] = y1.y; y[8 * q + 6] = y1.z; y[8 * q + 7] = y1.w; }
                    unpack8(*(const u32x4*)(AA + (size_t)t * RW + eq), av);
                    float r[8];
                    unpack8(*(const u32x4*)(row + 8 * q), z); unpack8(*(const u32x4*)(prow + 8 * q), zp);
                    { const f32x4 m0 = *(const f32x4*)(mu + eq), m1 = *(const f32x4*)(mu + eq + 4); cm[0] = m0.x; cm[1] = m0.y; cm[2] = m0.z; cm[3] = m0.w; cm[4] = m1.x; cm[5] = m1.y; cm[6] = m1.z; cm[7] = m1.w; }
#pragma unroll
                    for (int j = 0; j < 8; ++j) { const float p = tz ? 0.f : zp[j]; r[j] = z[j] + (p - z[j]) * cm[j]; }
                    unpack8(*(const u32x4*)(row + RW + 8 * q), z); unpack8(*(const u32x4*)(prow + RW + 8 * q), zp);
                    { const f32x4 m0 = *(const f32x4*)(mu + RW + eq), m1 = *(const f32x4*)(mu + RW + eq + 4); cm[0] = m0.x; cm[1] = m0.y; cm[2] = m0.z; cm[3] = m0.w; cm[4] = m1.x; cm[5] = m1.y; cm[6] = m1.z; cm[7] = m1.w; }
                    { const f32x4 k0 = *(const f32x4*)(args.in[I_KA] + eq), k1 = *(const f32x4*)(args.in[I_KA] + eq + 4); ck[0] = k0.x; ck[1] = k0.y; ck[2] = k0.z; ck[3] = k0.w; ck[4] = k1.x; ck[5] = k1.y; ck[6] = k1.z; ck[7] = k1.w; }
                    const f32x4 rk0 = *(const f32x4*)(args.in[I_RK] + eq), rk1 = *(const f32x4*)(args.in[I_RK] + eq + 4); const float rkk[8] = {rk0.x, rk0.y, rk0.z, rk0.w, rk1.x, rk1.y, rk1.z, rk1.w};
#pragma unroll
                    for (int j = 0; j < 8; ++j) { const float p = tz ? 0.f : zp[j]; const float kx = z[j] + (p - z[j]) * cm[j]; const float km = kx * (1.f + (av[j] - 1.f) * ck[j]);
                        s1 += y[8 * q + j]; sb += r[j] * km * rkk[j]; } }
                { float a_ = s1, b_ = s1; swap32(a_, b_); s1 = a_ + b_; float c_ = sb, d_ = sb; swap32(c_, d_); sb = c_ + d_; }
                const float mean = s1 * (1.f / 64.f); float s2 = 0.f;
#pragma unroll
                for (int j = 0; j < 32; ++j) { const float d = y[j] - mean; s2 += d * d; }
                { float a_ = s2, b_ = s2; swap32(a_, b_); s2 = a_ + b_; }
                const float rstd = rsqrtf(s2 * (1.f / 64.f) + LN_EPS);
#pragma unroll
                for (int q = 0; q < 4; ++q) { const int eq = e0 + 8 * q; float o[8], vs[8], gs[8];
                    { float z[8], zp[8]; unpack8(*(const u32x4*)(row + 2 * RW + 8 * q), z); unpack8(*(const u32x4*)(prow + 2 * RW + 8 * q), zp);
                      const f32x4 m0 = *(const f32x4*)(mu + 2 * RW + eq), m1 = *(const f32x4*)(mu + 2 * RW + eq + 4); const float cm[8] = {m0.x, m0.y, m0.z, m0.w, m1.x, m1.y, m1.z, m1.w};
#pragma unroll
                      for (int j = 0; j < 8; ++j) { const float p = tz ? 0.f : zp[j]; vs[j] = z[j] + (p - z[j]) * cm[j]; } }
                    unpack8(*(const u32x4*)(GG + (size_t)t * RW + eq), gs);
                    const f32x4 g0 = *(const f32x4*)(args.in[I_LNG] + eq), g1 = *(const f32x4*)(args.in[I_LNG] + eq + 4), b0 = *(const f32x4*)(args.in[I_LNB] + eq), b1 = *(const f32x4*)(args.in[I_LNB] + eq + 4);
                    const float lg[8] = {g0.x, g0.y, g0.z, g0.w, g1.x, g1.y, g1.z, g1.w}, lb[8] = {b0.x, b0.y, b0.z, b0.w, b1.x, b1.y, b1.z, b1.w};
#pragma unroll
                    for (int j = 0; j < 8; ++j) o[j] = ((y[8 * q + j] - mean) * rstd * lg[j] + lb[j] + sb * vs[j]) * gs[j];
                    u32x4 w; w.x = cvtpk(o[0], o[1]); w.y = cvtpk(o[2], o[3]); w.z = cvtpk(o[4], o[5]); w.w = cvtpk(o[6], o[7]);
                    *(u32x4*)(OB2 + (size_t)t * RW + eq) = w; }
            }
        }
    }
    SEAM(PH_RO);
    PHASE(PH_BR) { GAS unsigned char* wsl = (GAS unsigned char*)args.ws; asm volatile("" : "+s"(wsl));
        const bool conv_first = (((int)blockIdx.x >> 3) & 1) != 0;
#define BR_CONV() do { int lane_c = F.tid & 63; asm volatile("" : "+v"(lane_c)); LAS unsigned* scr64 = (LAS unsigned*)scr; \
            expert_conv_stream(CONV_EARLY + gw, CONV_SPLIT, NGW, args.in[I_WEG], args.in[I_WEU], args.in[I_WED], wsl, scr64, lane_c, args.in[I_GFFN]); \
            __syncthreads(); } while (0)
        if (conv_first) BR_CONV();
        { pg8::Gemm g{OA, WBR, 1024, 1024, 1024, nullptr}; pg8::StaticOrder S; S.init(T, DM, F.G, (int)blockIdx.x); pg8::EpiMerge<false> E{MERGED, PROJ + MLA_IN + RWKV_IN};
          pg8::gemm_phase<pg8::EpiMerge<false>, pg8::StaticOrder, false>(F.lds, g, S, E); }
        { pg8::Gemm g{(const bf16_t*)(wsl + WS_HB), WBR + (size_t)DM * 1024, 1024, 1024, 1024, nullptr}; pg8::StaticOrder S; S.init(T, DM, F.G, (int)blockIdx.x); pg8::EpiMerge<true> E{MERGED, PROJ + MLA_IN + RWKV_IN + DM};
          pg8::gemm_phase<pg8::EpiMerge<true>, pg8::StaticOrder, false>(F.lds, g, S, E); }
        __syncthreads();
        if (!conv_first) BR_CONV();
#undef BR_CONV
    }
    SEAM(PH_BR);
    PHASE(PH_OUT) { GAS unsigned char* wsl = (GAS unsigned char*)args.ws; asm volatile("" : "+s"(wsl));
        const bool conv_first = (((int)blockIdx.x >> 3) & 1) != 0;
#define OUT_CONV() do { int lane_c = F.tid & 63; asm volatile("" : "+v"(lane_c)); LAS unsigned* scr64 = (LAS unsigned*)scr; \
            expert_conv_stream(CONV_SPLIT + gw, (F.G >= 2 * (T / 256)) ? CONV_RT : NE * 768, NGW, args.in[I_WEG], args.in[I_WEU], args.in[I_WED], wsl, scr64, lane_c, args.in[I_GFFN]); \
            __syncthreads(); } while (0)
        if (conv_first) OUT_CONV();
        { pg8::Gemm g{MERGED, WOUT, DM, DM, DM, nullptr}; pg8::StaticOrder S; S.init(T, DM, F.G, (int)blockIdx.x); pg8::EpiResid E{X1B, X, SSQ1};
          pg8::gemm_phase<pg8::EpiResid, pg8::StaticOrder, false>(F.lds, g, S, E); }
        __syncthreads();
        if (!conv_first) OUT_CONV();
#undef OUT_CONV
    }
    SEAM(PH_OUT);
    PHASE(PH_RT) { GAS unsigned char* wsl = (GAS unsigned char*)args.ws; asm volatile("" : "+s"(wsl));
        constexpr int NRT = T / 256;
        const bool split = F.G >= 2 * NRT;
        if (!split || (int)blockIdx.x < NRT) {
            pg8::Gemm g{X1B, WRT, DM, DM, DM, nullptr}; pg8::StaticOrder S; S.init(T, NROUTE, split ? NRT : F.G, (int)blockIdx.x); pg8::EpiF32Rs E{LOGITS, NROUTE, SSQ1};
            pg8::gemm_phase<pg8::EpiF32Rs, pg8::StaticOrder, false>(F.lds, g, S, E);
            __syncthreads();
            pg8::Unit u;
            for (int i = 0; S.next(i, u); ++i) {
                if (F.tid < 256) { const int t = u.pm * 256 + F.tid;
                    const float* lg = LOGITS + (size_t)t * NROUTE; float gl[8]; int gi = 0; float gm = -3.4e38f;
#pragma unroll
                    for (int j = 0; j < 8; ++j) { gl[j] = lg[j] + args.in[I_BGRP][j]; if (gl[j] > gm) { gm = gl[j]; gi = j; } }
                    float gs = 0.f;
#pragma unroll
                    for (int j = 0; j < 8; ++j) gs += __expf(gl[j] - gm);
                    const float pg = 1.f / gs;
                    float el[8]; int i0 = 0; float m0 = -3.4e38f;
#pragma unroll
                    for (int j = 0; j < 8; ++j) { el[j] = lg[8 + gi * 8 + j] + args.in[I_BEXP][gi * 8 + j]; if (el[j] > m0) { m0 = el[j]; i0 = j; } }
                    int i1 = 0; float m1 = -3.4e38f;
#pragma unroll
                    for (int j = 0; j < 8; ++j) if (j != i0 && el[j] > m1) { m1 = el[j]; i1 = j; }
                    const float x1 = __expf(m1 - m0), w0 = pg / (1.f + x1), w1 = pg * x1 / (1.f + x1);
                    const int e0 = gi * 8 + i0, e1 = gi * 8 + i1;
                    const unsigned p0 = __hip_atomic_fetch_add(CNT + e0, 1u, RLX_AGENT), p1 = __hip_atomic_fetch_add(CNT + e1, 1u, RLX_AGENT);
                    TOKE[2 * t] = e0; TOKE[2 * t + 1] = e1; TOKP[2 * t] = (int)p0; TOKP[2 * t + 1] = (int)p1; TOKW[2 * t] = w0; TOKW[2 * t + 1] = w1; }
            }
        }
        if (!split || (int)blockIdx.x >= NRT) {
            pg8::Gemm g{PB, WPP, PLE, PLE, PLE, nullptr}; pg8::StaticOrder S; S.init(T, DM, split ? F.G - NRT : F.G, split ? (int)blockIdx.x - NRT : (int)blockIdx.x); pg8::EpiBf16Ssq E{PLEB, DM, SSQP};
            pg8::gemm_phase<pg8::EpiBf16Ssq, pg8::StaticOrder, false>(F.lds, g, S, E);
            if (split) {
                __syncthreads();
                int lane_c = F.tid & 63; asm volatile("" : "+v"(lane_c)); LAS unsigned* scr64 = (LAS unsigned*)scr;
                expert_conv_stream(CONV_RT + ((int)blockIdx.x - NRT) * NWAVES + F.wave, NE * 768, (F.G - NRT) * NWAVES, args.in[I_WEG], args.in[I_WEU], args.in[I_WED], wsl, scr64, lane_c, args.in[I_GFFN]);
                __syncthreads(); }
        }
    }
    SEAM(PH_RT);
    LAS int* tstart = (LAS int*)(F.lds + TAB_OFF); LAS int* ulist = tstart + 72;
    if (IN(PH_SCAT) || IN(PH_GU) || IN(PH_DN)) {
        if (F.tid == 0) { int acc = 0; for (int e = 0; e < NE; ++e) { tstart[e] = acc; acc += ((int)__hip_atomic_load(CNT + e, RLX_AGENT) + 255) >> 8; } tstart[NE] = acc; }
        __syncthreads();
    }
    PHASE(PH_SCAT) { GAS unsigned char* wsl = (GAS unsigned char*)args.ws; asm volatile("" : "+s"(wsl));
        for (int t = blockIdx.x * 512 + F.tid; t < T; t += F.G * 512) {
#pragma unroll
            for (int k = 0; k < 2; ++k) { const int e = TOKE[2 * t + k], slot = tstart[e] * 256 + TOKP[2 * t + k]; ROWTOK[slot] = t; TOKP[2 * t + k] = slot; } }
    }
    SEAM(PH_SCAT);
    PHASE(PH_GU) { GAS unsigned char* wsl = (GAS unsigned char*)args.ws; asm volatile("" : "+s"(wsl));
        const int total = tstart[NE] * 4; int n = 0;
        if (F.tid == 0) { for (int L = blockIdx.x; L < total && n < 64; L += F.G, ++n) { const int mt = L >> 2; int e = 0; while (tstart[e + 1] <= mt) ++e; ulist[2 * n] = mt; ulist[2 * n + 1] = e * 4 + (L & 3); } ulist[128] = n; }
        __syncthreads();
        pg8::ListOrder S{ulist, ulist[128], (const char*)(wsl + WS_WGU_A), (const char*)(wsl + WS_WGU_B), WGU_SPLIT, 4, (size_t)(4 * MiB)}; pg8::Gemm g{X1B, nullptr, DM, DM, DM, ROWTOK}; pg8::EpiSwiGLU E{ACT, ROWTOK, SSQ1};
        pg8::gemm_phase<pg8::EpiSwiGLU, pg8::ListOrder, true>(F.lds, g, S, E);
        __syncthreads();
    }
    SEAM(PH_GU);
    PHASE(PH_DN) { GAS unsigned char* wsl = (GAS unsigned char*)args.ws; asm volatile("" : "+s"(wsl));
        const int total = tstart[NE] * 8; int n = 0;
        if (F.tid == 0) { for (int L = blockIdx.x; L < total && n < 64; L += F.G, ++n) { const int mt = L >> 3; int e = 0; while (tstart[e + 1] <= mt) ++e; ulist[2 * n] = mt; ulist[2 * n + 1] = e * 8 + (L & 7); } ulist[128] = n; }
        __syncthreads();
        pg8::ListOrder S{ulist, ulist[128], (const char*)(wsl + WS_WD), (const char*)(wsl + WS_WD), NE, 8, (size_t)(2 * MiB)}; pg8::Gemm g{ACT, nullptr, DE, DE, DE, nullptr}; pg8::EpiDown E{YB};
        pg8::gemm_phase<pg8::EpiDown, pg8::ListOrder, false>(F.lds, g, S, E);
        __syncthreads();
    }
    SEAM(PH_DN);
    PHASE(PH_E4) { GAS unsigned char* wsl = (GAS unsigned char*)args.ws; asm volatile("" : "+s"(wsl)); int lane_l = F.tid & 63; asm volatile("" : "+v"(lane_l)); const int lane = lane_l;
        int s0n = 0, s1n = 0; float w0n = 0.f, w1n = 0.f;
        if (gw < T) { s0n = TOKP[2 * gw]; s1n = TOKP[2 * gw + 1]; w0n = TOKW[2 * gw]; w1n = TOKW[2 * gw + 1]; }
        for (int t = gw; t < T; t += NGW) {
            const int s0 = s0n, s1 = s1n; const float w0 = w0n, w1 = w1n;
            const u32x2* xr = (const u32x2*)(X1B + (size_t)t * DM) + lane; u32x2* xo = (u32x2*)(X2B + (size_t)t * DM) + lane; const u32x2* y0 = (const u32x2*)(YB + (size_t)s0 * DM) + lane; const u32x2* y1 = (const u32x2*)(YB + (size_t)s1 * DM) + lane;
            f32x4 v[8]; u32x2 ya[8], yb[8];
#pragma unroll
            for (int j = 0; j < 8; ++j) { const u32x2 xw = __builtin_nontemporal_load(xr + 64 * j); v[j] = (f32x4){bflo(xw.x), bfhi(xw.x), bflo(xw.y), bfhi(xw.y)}; ya[j] = __builtin_nontemporal_load(y0 + 64 * j); yb[j] = __builtin_nontemporal_load(y1 + 64 * j); }
            if (t + NGW < T) { const int tn = t + NGW; s0n = TOKP[2 * tn]; s1n = TOKP[2 * tn + 1]; w0n = TOKW[2 * tn]; w1n = TOKW[2 * tn + 1]; }
            float s = 0.f;
#pragma unroll
            for (int j = 0; j < 8; ++j) { const u32x2 a = ya[j], b = yb[j];
                v[j].x += w0 * bflo(a.x) + w1 * bflo(b.x); v[j].y += w0 * bfhi(a.x) + w1 * bfhi(b.x); v[j].z += w0 * bflo(a.y) + w1 * bflo(b.y); v[j].w += w0 * bfhi(a.y) + w1 * bfhi(b.y);
                s += (v[j].x * v[j].x + v[j].y * v[j].y) + (v[j].z * v[j].z + v[j].w * v[j].w); }
#pragma unroll
            for (int o = 1; o < 64; o <<= 1) s += __shfl_xor(s, o);
#pragma unroll
            for (int j = 0; j < 8; ++j) { u32x2 xw; xw.x = cvtpk(v[j].x, v[j].y); xw.y = cvtpk(v[j].z, v[j].w); xo[64 * j] = xw; }
            if (lane == 0) RSTD2[t] = rsqrtf(s * (1.f / DM) + EPS);
        }
    }
    SEAM(PH_E4);
    PHASE(PH_PLE) { GAS unsigned char* wsl = (GAS unsigned char*)args.ws; asm volatile("" : "+s"(wsl));
        pg8::Gemm g{X2B, WPG, DM, DM, DM, nullptr}; pg8::StaticOrder S; S.init(T, DM, F.G, (int)blockIdx.x); pg8::EpiPle E{OUT, X2B, PLEB, SSQP, RSTD2, args.in[I_GPP]};
        pg8::gemm_phase<pg8::EpiPle, pg8::StaticOrder, false>(F.lds, g, S, E);
    }
#undef IN
#undef SEAM
}

#undef WIN
#undef WQB
#undef WKVB
#undef W2T
#undef A2T
#undef G2T
#undef WBR
#undef WOUT
#undef WRT
#undef WPG
#undef WPP
#undef HB
#undef PB
#undef TAB
#undef PROJ
#undef QB_
#undef KVB
#undef K2B
#undef OA
#undef OB
#undef LW
#undef AA
#undef GG
#undef TW
#undef ZA
#undef SG
#undef MERGED
#undef YR
#undef WGU_E
#undef WD_E
#undef RSTD2
#undef ACT
#undef YB
#undef LOGITS
#undef PLEB
#undef RSTDQ
#undef RSTDKV
#undef RSTDPLE
#undef TOKE
#undef TOKP
#undef TOKW
#undef ROWTOK
#undef X1B
#undef X2B
#undef CNT
#undef PGF
#undef LGF
#undef GSF
#undef PRM
#undef VM
#undef PT
#undef LL
#undef QQ
#undef SC
extern "C" void kernel_launch(void* const* d_in, const int* in_sizes, int n_in, void* d_out, int out_size, void* d_ws, size_t ws_size, hipStream_t stream) {
    static int grid = 0;
    if (grid == 0) {
        if (n_in != 36 || in_sizes[0] != T * DM || out_size != T * DM || ws_size < WS_END) { fprintf(stderr, "kernel_launch: shape mismatch n_in %d in0 %d out %d ws %zu (need %zu)\n", n_in, n_in > 0 ? in_sizes[0] : -1, out_size, ws_size, (size_t)WS_END); grid = -1; return; }
        int dev = 0, cus = 0, per_cu = 0;
        if (hipGetDevice(&dev) != hipSuccess || hipDeviceGetAttribute(&cus, hipDeviceAttributeMultiprocessorCount, dev) != hipSuccess) { grid = -1; return; }
        if (hipFuncSetAttribute((const void*)mega, hipFuncAttributeMaxDynamicSharedMemorySize, LDS_BYTES) != hipSuccess) { fprintf(stderr, "kernel_launch: hipFuncSetAttribute failed\n"); grid = -1; return; }
        if (hipOccupancyMaxActiveBlocksPerMultiprocessor(&per_cu, (const void*)mega, NWAVES * 64, LDS_BYTES) != hipSuccess || per_cu < 1) fprintf(stderr, "kernel_launch: occupancy query says %d\n", per_cu);
        (void)hipGetLastError();
        grid = cus;
    }
    if (grid < 0) return;
    (void)hipMemsetAsync((char*)d_ws + WS_CTL, 0, CTL_ZERO_BYTES, stream);
    Args a{};
    for (int i = 0; i < 36; ++i) a.in[i] = (const float*)d_in[i];
    a.out = (float*)d_out; a.ws = (unsigned char*)d_ws;
    for (int i = 0; i < 32; ++i) a.inv_freq[i] = (float)(1.0 / pow(10000.0, (double)(2 * i) / 64.0));
#if MK_ONE_LAUNCH
    if (PROBE_PH < 0) { a.ph_lo = 0; a.ph_hi = N_PHASES; a.li = 0; hipLaunchKernelGGL(mega, dim3(grid), dim3(NWAVES * 64), LDS_BYTES, stream, a); }
    else {
        for (int r = 1; r < PROBE_N; ++r) { a.ph_lo = PROBE_PH; a.ph_hi = PROBE_PH + 1; a.li = 1; hipLaunchKernelGGL(mega, dim3(grid), dim3(NWAVES * 64), LDS_BYTES, stream, a); }
        a.ph_lo = 0; a.ph_hi = N_PHASES; a.li = 0; hipLaunchKernelGGL(mega, dim3(grid), dim3(NWAVES * 64), LDS_BYTES, stream, a);
    }
#else
    for (int p = 0; p < N_PHASES; ++p) { a.ph_lo = p; a.ph_hi = p + 1; a.li = 0; hipLaunchKernelGGL(mega, dim3(grid), dim3(NWAVES * 64), LDS_BYTES, stream, a); }
#endif
}
```

```cpp
#include <hip/hip_runtime.h>
#include <cstdio>
#include <cstdint>
#include <cmath>

#ifndef MK_ONE_LAUNCH
#define MK_ONE_LAUNCH 1
#endif

#define GAS __attribute__((address_space(1)))
#define LAS __attribute__((address_space(3)))
typedef unsigned short bf16_t;
typedef short bf16x8 __attribute__((ext_vector_type(8)));
typedef short s16x4 __attribute__((ext_vector_type(4)));
typedef float f32x4 __attribute__((ext_vector_type(4)));
typedef float f32x2 __attribute__((ext_vector_type(2)));
typedef float f32x16 __attribute__((ext_vector_type(16)));
typedef unsigned u32x4 __attribute__((ext_vector_type(4)));
typedef unsigned u32x2 __attribute__((ext_vector_type(2)));
typedef GAS unsigned gu32;

constexpr int T = 16384, DM = 2048;
constexpr int QL = 512, KVL = 512, ROPE = 64, NOPE = 128, QKD = 192, VD = 128, NH = 8;
constexpr int MLA_IN = QL + KVL + ROPE;
constexpr int RW = 1024, RH = 16, RN = 64, DLORA = 96, ALORA = 96, GLORA = 256;
constexpr int RWKV_IN = 3 * RW + DLORA + ALORA + GLORA;
constexpr int GATE_IN = 2 * DM;
constexpr int IN_TOTAL = MLA_IN + RWKV_IN + GATE_IN;
constexpr int NG = 8, EPG = 8, NE = 64, DE = 512;
constexpr int PLE = 256;
constexpr float EPS = 1e-6f, LN_EPS = 64e-5f;
constexpr int MAXTILES = 192;
constexpr int NSLOT = MAXTILES * 256;
constexpr int NROUTE = 256;

constexpr size_t MiB = 1u << 20;
constexpr size_t WS_CTL = 0, CTL_ZERO_BYTES = 1 * MiB;
constexpr size_t WS_WIN = 1 * MiB;
constexpr size_t WS_WQB = 35 * MiB;
constexpr size_t WS_WKVB = 37 * MiB;
constexpr size_t WS_W2T = 39 * MiB;
constexpr size_t WS_A2T = WS_W2T + 256 * 1024;
constexpr size_t WS_G2T = WS_W2T + 512 * 1024;
constexpr size_t WS_WBR = 40 * MiB;
constexpr size_t WS_WOUT = 48 * MiB;
constexpr size_t WS_WRT = 56 * MiB;
constexpr size_t WS_WPG = 57 * MiB;
constexpr size_t WS_WPP = 65 * MiB;
constexpr size_t WS_HB = 66 * MiB;
constexpr size_t WS_PB = 130 * MiB;
constexpr size_t WS_SMALL = 138 * MiB;
constexpr size_t WS_TAB = 144 * MiB;
constexpr size_t WS_BIG = 148 * MiB;
constexpr size_t WS_PROJ = WS_BIG;
constexpr size_t WS_Q = WS_PROJ + 272 * MiB;
constexpr size_t WS_KV = WS_Q + 48 * MiB;
constexpr size_t WS_KR = WS_KV + 64 * MiB;
constexpr size_t WS_OA = WS_KR + 48 * MiB;
constexpr size_t WS_OB = WS_OA + 32 * MiB;
constexpr size_t WS_LW = WS_OB + 32 * MiB;
constexpr size_t WS_AA = WS_LW + 64 * MiB;
constexpr size_t WS_GG = WS_AA + 32 * MiB;
constexpr size_t WS_TW = WS_GG + 32 * MiB;
constexpr size_t WS_ZA = WS_TW + 4 * MiB;
constexpr size_t WS_SG = WS_ZA + 4 * MiB;
constexpr size_t WS_MERGED = WS_SG + 8 * MiB;
constexpr size_t WS_YR = WS_MERGED + 64 * MiB;
constexpr size_t WS_PT = WS_YR + 64 * MiB;
constexpr size_t WS_LL = WS_PT + 32 * MiB;
constexpr size_t WS_MIX_END = WS_LL + 32 * MiB;
constexpr size_t WS_WGU_A = WS_Q;
constexpr size_t WS_WGU_B = WS_LW;
constexpr int WGU_SPLIT = 40;
constexpr size_t WS_WD = WS_YR;
constexpr size_t WS_X1B = WS_BIG;
constexpr size_t WS_Y = WS_X1B + 64 * MiB;
constexpr size_t WS_LOGITS = WS_Y + 192 * MiB;
constexpr size_t WS_ACT = WS_OA;
constexpr size_t WS_PLE = WS_MERGED;
constexpr size_t WS_X2B = WS_HB;
static_assert(WS_WGU_A + 40 * 4 * MiB <= WS_OA && WS_WGU_B + 24 * 4 * MiB <= WS_GG && WS_WD + 128 * MiB <= 1036 * MiB && WS_LOGITS + 16 * MiB <= WS_Q && WS_ACT + 48 * MiB <= WS_LW, "moe overlay");
constexpr size_t WS_MOE_END = WS_WD + 128 * MiB;
constexpr size_t WS_END = (WS_MIX_END > WS_MOE_END ? WS_MIX_END : WS_MOE_END);
static_assert(WS_END <= 1000 * MiB, "workspace map");
constexpr size_t SM_RSTDQ = 0, SM_RSTDKV = 64 * 1024, SM_RSTDPLE = 128 * 1024;
constexpr size_t SM_RSTD2 = 768 * 1024;
constexpr size_t SM_TOKE = 192 * 1024;
constexpr size_t SM_TOKP = 320 * 1024;
constexpr size_t SM_TOKW = 448 * 1024;
constexpr size_t SM_ROWTOK = 576 * 1024;
constexpr size_t SM_END = 832 * 1024;
constexpr int CW_BAR = 4096;
constexpr int CW_CNT = 16384;

constexpr int RING_BYTES = 131072;
constexpr int MISC_OFF = RING_BYTES;
constexpr int TAB_OFF = RING_BYTES + 256;
constexpr int LDS_BYTES = 147456;
constexpr int NWAVES = 8;

#define RLX_AGENT __ATOMIC_RELAXED, __HIP_MEMORY_SCOPE_AGENT
#define LDS_WAIT() asm volatile("s_waitcnt lgkmcnt(0)" ::: "memory")
#define VM_WAIT() asm volatile("s_waitcnt vmcnt(0)" ::: "memory")
__device__ __forceinline__ unsigned f2bf(float f) { unsigned u = __builtin_bit_cast(unsigned, f); return (u + 0x7fffu + ((u >> 16) & 1u)) >> 16; }
__device__ __forceinline__ unsigned pk2(float lo, float hi) { return f2bf(lo) | (f2bf(hi) << 16); }
__device__ __forceinline__ float bf2f(unsigned short b) { return __builtin_bit_cast(float, (unsigned)b << 16); }
__device__ __forceinline__ float bflo(unsigned w) { return __builtin_bit_cast(float, w << 16); }
__device__ __forceinline__ float bfhi(unsigned w) { return __builtin_bit_cast(float, w & 0xffff0000u); }
__device__ __forceinline__ unsigned cvtpk(float lo, float hi) { unsigned r; asm volatile("v_cvt_pk_bf16_f32 %0, %1, %2" : "=v"(r) : "v"(lo), "v"(hi)); return r; }
__device__ __forceinline__ float wave_sum(float v) {
#pragma unroll
    for (int o = 1; o < 64; o <<= 1) v += __shfl_xor(v, o);
    return v;
}
__device__ __forceinline__ float sigmoidf_(float x) { return 1.f / (1.f + __expf(-x)); }

#define XB_TMO      128
#define XB_XCNT(j)  (256  + 64 * (j))
#define XB_XSUB(j)  (1280 + 64 * (j))
#define XB_XGEN(j)  (2304 + 64 * (j))
#define XB_TOP      3328
#define XB_TOPGEN   3392
#define XCD_BAR_WORDS 3456
#define XB_SPIN_CAP (1u << 18)
__device__ __forceinline__ unsigned xb_ld(unsigned* p)              { return __hip_atomic_load(p, __ATOMIC_RELAXED, __HIP_MEMORY_SCOPE_AGENT); }
__device__ __forceinline__ unsigned xb_add(unsigned* p, unsigned v) { return __hip_atomic_fetch_add(p, v, __ATOMIC_RELAXED, __HIP_MEMORY_SCOPE_AGENT); }
__device__ __forceinline__ unsigned xb_xcc_id() { return (unsigned)__builtin_amdgcn_s_getreg((3 << 11) | 20) & 0xFu; }
#define XB_SPIN(cond, bar) do { unsigned _sp = 0; while (cond) { __builtin_amdgcn_s_sleep(1); \
    if ((++_sp & 255u) == 0u) { if (xb_ld(&(bar)[XB_TMO])) break; if (_sp > XB_SPIN_CAP) { atomicAdd(&(bar)[XB_TMO], 1u); break; } } } } while (0)
struct XcdBarrier { unsigned* bar; unsigned x; volatile LAS unsigned* st; };
__device__ __forceinline__ XcdBarrier xcd_barrier_post(unsigned* bar, volatile LAS unsigned* st) {
    XcdBarrier b; b.bar = bar; b.x = xb_xcc_id(); b.st = st;
    if (threadIdx.x == 0) (void)xb_add(&bar[XB_XCNT(b.x)], 1u);
    return b;
}
__device__ __forceinline__ void xcd_barrier_complete(unsigned* bar, unsigned x, unsigned& nloc, unsigned& nx) {
    const unsigned G = gridDim.x * gridDim.y * gridDim.z;
    unsigned sum, cnt, mine, sp = 0u;
    for (;;) {
        sum = 0u; cnt = 0u; mine = 0u;
#pragma unroll
        for (unsigned j = 0; j < 16; ++j) { const unsigned c = xb_ld(&bar[XB_XCNT(j)]); sum += c; cnt += (c > 0u) ? 1u : 0u; mine = (j == x) ? c : mine; }
        if (sum == G) break;
        __builtin_amdgcn_s_sleep(1);
        if ((++sp & 255u) == 0u) { if (xb_ld(&bar[XB_TMO])) break; if (sp > XB_SPIN_CAP) { atomicAdd(&bar[XB_TMO], 1u); break; } }
    }
    nloc = mine > 0u ? mine : 1u; nx = cnt > 0u ? cnt : 1u;
}
__device__ __forceinline__ void xcd_barrier(const XcdBarrier& b) {
    asm volatile("s_waitcnt vmcnt(0)" ::: "memory");
    __syncthreads();
    if (threadIdx.x == 0) {
        unsigned* bar = b.bar;
        __builtin_amdgcn_s_waitcnt(0);
        unsigned nloc = b.st[0], nx = b.st[1];
        if (nloc == 0u) { xcd_barrier_complete(bar, b.x, nloc, nx); b.st[0] = nloc; b.st[1] = nx; }
        const unsigned old = xb_add(&bar[XB_XSUB(b.x)], 1u);
        const unsigned gen = old / nloc;
        if (old + 1u == (gen + 1u) * nloc) {
            __builtin_amdgcn_fence(__ATOMIC_RELEASE, "agent");
            asm volatile("s_waitcnt vmcnt(0)" ::: "memory");
            const unsigned og = xb_add(&bar[XB_TOP], 1u);
            const unsigned tg = og / nx;
            if (og + 1u == (tg + 1u) * nx) xb_add(&bar[XB_TOPGEN], 1u);
            else XB_SPIN(xb_ld(&bar[XB_TOPGEN]) == tg, bar);
            __builtin_amdgcn_fence(__ATOMIC_ACQUIRE, "agent");
            xb_add(&bar[XB_XGEN(b.x)], 1u);
            asm volatile("s_waitcnt vmcnt(0)" ::: "memory");
        } else {
            XB_SPIN(xb_ld(&bar[XB_XGEN(b.x)]) == gen, bar);
            __builtin_amdgcn_fence(__ATOMIC_ACQUIRE, "agent");
            asm volatile("s_waitcnt vmcnt(0)" ::: "memory");
        }
    }
    __syncthreads();
}

namespace pg8 {
constexpr int BM = 256, BK = 64, HALF = 128, HTB = HALF * BK * 2, NXCD = 8, WGM = 8;
__host__ __device__ __forceinline__ int lds_byte(int r, int c) { const int st = (r >> 4) * 2 + (c >> 5), rr = r & 15, cc = c & 31, ob = rr * 64 + cc * 2; return st * 1024 + (ob ^ (((ob >> 9) & 1) << 5)); }
__host__ __device__ __forceinline__ void stage_rc(int b, int& R, int& C) { const int st = b / 1024, sb = b % 1024, swz = sb ^ (((sb >> 9) & 1) << 5); R = (st >> 1) * 16 + swz / 64; C = (st & 1) * 32 + (swz % 64) / 2; }
__host__ __device__ __forceinline__ int perm32(int rho) { const int n = rho >> 4, i = rho & 15; return 8 * (i >> 2) + 4 * n + (i & 3); }
struct Unit { int pm, pn; };
struct Gemm { const bf16_t* A; const bf16_t* Bt; int lda, ldb, K; const int* rowtok; };

struct StaticOrder {
    int nM, nN, nwg, G, c;
    __device__ __forceinline__ void init(int M, int N, int G_, int c_) { nM = M / BM; nN = N / BM; nwg = nM * nN; G = G_; c = c_; }
    __device__ __forceinline__ bool next(int i, Unit& u) const {
        const long L = (long)i * G + c; if (L >= nwg) return false;
        int wgid = (int)L; { const int q = nwg / NXCD, r = nwg % NXCD, xcd = wgid % NXCD, off = wgid / NXCD; wgid = (xcd < r ? xcd * (q + 1) : r * (q + 1) + (xcd - r) * q) + off; }
        const int nig = WGM * nN, gid = wgid / nig, fm = gid * WGM, gsz = (nM - fm) < WGM ? (nM - fm) : WGM;
        u.pm = fm + ((wgid % nig) % gsz); u.pn = (wgid % nig) / gsz; return true;
    }
    __device__ __forceinline__ const char* bptr(const Gemm& g, const Unit& u, size_t tstepB) const { return (const char*)g.Bt + (size_t)u.pn * tstepB; }
};
struct ListOrder {
    const LAS int* tab; int n;
    const char* base_a; const char* base_b; int split_e, npn; size_t estride;
    __device__ __forceinline__ const char* bptr(const Gemm&, const Unit& u, size_t tstepB) const { const int e = u.pn / npn, l = u.pn % npn;
        return (e < split_e ? base_a + (size_t)e * estride : base_b + (size_t)(e - split_e) * estride) + (size_t)l * tstepB; }
    __device__ __forceinline__ bool next(int i, Unit& u) const { if (i >= n) return false; u.pm = tab[2 * i]; u.pn = tab[2 * i + 1]; return true; }
};

template <class Epi, class Sched, bool GATHER>
__device__ __forceinline__ void gemm_phase(LAS unsigned char* lds, const Gemm g, const Sched& S, const Epi& E) {
    int tid_ = threadIdx.x; asm volatile("" : "+v"(tid_));
    const int tid = tid_, wid = __builtin_amdgcn_readfirstlane(tid >> 6), lane = tid & 63, wr = wid >> 2, wc = wid & 3, fr = lane & 15, fq = lane >> 4;
    const int K = g.K, nt = K / BK;
    unsigned voffA[2], voffB[2]; int RA[2], CA[2];
#pragma unroll
    for (int i = 0; i < 2; ++i) { int R, C; stage_rc(tid * 16 + i * 8192, R, C); const int Rb = (R & ~31) + perm32(R & 31);
        RA[i] = R; CA[i] = C; voffA[i] = (unsigned)(R * g.lda + C) * 2u; voffB[i] = (unsigned)(Rb * g.ldb + C) * 2u; }
    const size_t kstep = (size_t)(BK * 2);
    const size_t hstepA = (size_t)HALF * g.lda * 2, hstepB = (size_t)HALF * g.ldb * 2;
    const size_t tstepA = 2 * hstepA, tstepB = 2 * hstepB;
    const unsigned ldsw = (unsigned)wid * 1024u;
    const int aoff = lds_byte(wr * 64 + fr, fq * 8), boff = lds_byte(wc * 32 + fr, fq * 8);
#define PG8_SA(b, h) (((b) * 2 + (h)) * HTB)
#define PG8_SB(b, h) ((4 + (b) * 2 + (h)) * HTB)
#define PG8_STAGE(bufoff, gbase, voff) do { _Pragma("unroll") for (int _i = 0; _i < 2; ++_i) \
        __builtin_amdgcn_global_load_lds((const unsigned*)((const char*)(gbase) + (voff)[_i]), (LAS unsigned*)(lds + (bufoff) + ldsw + _i * 8192), 16, 0, 0); } while (0)
#define PG8_LDA(dst, b, h) do { _Pragma("unroll") for (int m = 0; m < 4; ++m) _Pragma("unroll") for (int k = 0; k < 2; ++k) dst[m][k] = *(const LAS bf16x8*)(lds + PG8_SA(b, h) + aoff + m * 2048 + k * 1024); } while (0)
#define PG8_LDB(dst, b, h) do { _Pragma("unroll") for (int n = 0; n < 2; ++n) _Pragma("unroll") for (int k = 0; k < 2; ++k) dst[n][k] = *(const LAS bf16x8*)(lds + PG8_SB(b, h) + boff + n * 2048 + k * 1024); } while (0)
#define PG8_MMA(ai, bj, At, Bt) do { __builtin_amdgcn_s_setprio(1); _Pragma("unroll") for (int m = 0; m < 4; ++m) _Pragma("unroll") for (int n = 0; n < 2; ++n) _Pragma("unroll") for (int k = 0; k < 2; ++k) \
        acc[ai][bj][m][n] = __builtin_amdgcn_mfma_f32_16x16x32_bf16(Bt[n][k], At[m][k], acc[ai][bj][m][n], 0, 0, 0); __builtin_amdgcn_s_setprio(0); } while (0)
#define PG8_WAIT_V(n) asm volatile("s_waitcnt vmcnt(" #n ")" ::: "memory")
#define PG8_WAIT_L(n) asm volatile("s_waitcnt lgkmcnt(" #n ")" ::: "memory")
#define PG8_BAR __builtin_amdgcn_s_barrier()
#define PG8_SCHED __builtin_amdgcn_sched_barrier(0)
#define PG8_GOFF(dst, u) do { _Pragma("unroll") for (int _h = 0; _h < 2; ++_h) _Pragma("unroll") for (int _i = 0; _i < 2; ++_i) { \
        int _t = __hip_atomic_load(g.rowtok + (u).pm * BM + _h * HALF + RA[_i], RLX_AGENT); if ((unsigned)_t >= (unsigned)T) _t = 0; \
        dst[_h][_i] = (unsigned)(_t * g.lda + CA[_i]) * 2u; } } while (0)
#define PG8_STAGE_A(b, h, tileptr, koff, goff) do { if constexpr (GATHER) { PG8_STAGE(PG8_SA(b, h), (const char*)g.A + (koff), (goff)[h]); } \
        else { PG8_STAGE(PG8_SA(b, h), (tileptr) + (h) * hstepA + (koff), voffA); } } while (0)
    Unit cur, nxt; int ui = 0;
    if (!S.next(0, cur)) return;
    f32x4 acc[2][2][4][2];
#pragma unroll
    for (int a = 0; a < 2; ++a)
#pragma unroll
        for (int b = 0; b < 2; ++b)
#pragma unroll
            for (int m = 0; m < 4; ++m)
#pragma unroll
                for (int n = 0; n < 2; ++n) acc[a][b][m][n] = (f32x4){0.f, 0.f, 0.f, 0.f};
    bf16x8 At[4][2], B0[2][2], B1[2][2];
    unsigned goC[2][2] = {{0u, 0u}, {0u, 0u}}, goN[2][2] = {{0u, 0u}, {0u, 0u}};
    const char* cA = (const char*)g.A + (GATHER ? (size_t)0 : (size_t)cur.pm * tstepA); const char* cB = S.bptr(g, cur, tstepB);
    if constexpr (GATHER) { PG8_GOFF(goC, cur); }
    PG8_STAGE(PG8_SB(0, 0), cB, voffB); PG8_STAGE(PG8_SB(0, 1), cB + hstepB, voffB); PG8_STAGE_A(0, 0, cA, 0, goC); PG8_STAGE_A(0, 1, cA, 0, goC);
    if (wr == 1) PG8_BAR;
    PG8_WAIT_V(2); PG8_BAR;
    PG8_STAGE(PG8_SB(1, 0), cB + kstep, voffB); PG8_STAGE_A(1, 0, cA, kstep, goC); PG8_STAGE(PG8_SB(1, 1), cB + hstepB + kstep, voffB);
    PG8_WAIT_V(6); PG8_BAR;
    for (;;) {
        const bool has_next = S.next(ui + 1, nxt);
        const char* nA = (has_next && !GATHER) ? (const char*)g.A + (size_t)nxt.pm * tstepA : cA; const char* nB = has_next ? S.bptr(g, nxt, tstepB) : cB;
        if constexpr (GATHER) { if (has_next) { PG8_GOFF(goN, nxt); } else {
#pragma unroll
            for (int h = 0; h < 2; ++h)
#pragma unroll
                for (int i = 0; i < 2; ++i) goN[h][i] = goC[h][i]; } }
        for (int t = 0; t < nt; t += 2) {
            const bool last = (t == nt - 2);
            const size_t k1 = (size_t)(t + 1) * kstep, k2 = last ? (size_t)0 : (size_t)(t + 2) * kstep, k3 = k2 + kstep;
            const char* a2 = last ? nA : cA; const char* b2 = (last ? nB : cB) + k2; const char* b3 = b2 + kstep;
            unsigned go2[2][2];
#pragma unroll
            for (int h = 0; h < 2; ++h)
#pragma unroll
                for (int i = 0; i < 2; ++i) go2[h][i] = last ? goN[h][i] : goC[h][i];
            PG8_LDB(B0, 0, 0); PG8_LDB(B1, 0, 1); PG8_SCHED; PG8_LDA(At, 0, 0); PG8_STAGE_A(1, 1, cA, k1, goC);
            PG8_WAIT_V(8); PG8_WAIT_L(0); PG8_BAR; PG8_MMA(0, 0, At, B0); PG8_MMA(0, 1, At, B1); PG8_BAR; PG8_SCHED;
            PG8_LDA(At, 0, 1); PG8_STAGE(PG8_SB(0, 0), b2, voffB); PG8_STAGE(PG8_SB(0, 1), b2 + hstepB, voffB); PG8_STAGE_A(0, 0, a2, k2, go2);
            PG8_WAIT_V(8); PG8_WAIT_L(0); PG8_BAR; PG8_MMA(1, 0, At, B0); PG8_MMA(1, 1, At, B1); PG8_BAR; PG8_SCHED;
            PG8_LDB(B0, 1, 0); PG8_LDB(B1, 1, 1); PG8_SCHED; PG8_LDA(At, 1, 0); PG8_STAGE_A(0, 1, a2, k2, go2);
            PG8_WAIT_V(8); PG8_WAIT_L(0); PG8_BAR; PG8_MMA(0, 0, At, B0); PG8_MMA(0, 1, At, B1); PG8_BAR; PG8_SCHED;
            PG8_LDA(At, 1, 1); PG8_STAGE(PG8_SB(1, 0), b3, voffB); PG8_STAGE(PG8_SB(1, 1), b3 + hstepB, voffB); PG8_STAGE_A(1, 0, a2, k3, go2);
            PG8_WAIT_V(8); PG8_WAIT_L(0); PG8_BAR; PG8_MMA(1, 0, At, B0); PG8_MMA(1, 1, At, B1); PG8_BAR; PG8_SCHED;
        }
        if (wr == 0) PG8_BAR;
        E(acc, cur, wr, wc, fr, fq);
        if (!has_next) break;
#pragma unroll
        for (int a = 0; a < 2; ++a)
#pragma unroll
            for (int b = 0; b < 2; ++b)
#pragma unroll
                for (int m = 0; m < 4; ++m)
#pragma unroll
                    for (int n = 0; n < 2; ++n) acc[a][b][m][n] = (f32x4){0.f, 0.f, 0.f, 0.f};
        cur = nxt; cA = nA; cB = nB; ++ui;
#pragma unroll
        for (int h = 0; h < 2; ++h)
#pragma unroll
            for (int i = 0; i < 2; ++i) goC[h][i] = goN[h][i];
        if (wr == 1) PG8_BAR;
    }
    PG8_WAIT_V(0);
    PG8_BAR;
#undef PG8_SA
#undef PG8_SB
#undef PG8_STAGE
#undef PG8_LDA
#undef PG8_LDB
#undef PG8_MMA
#undef PG8_WAIT_V
#undef PG8_WAIT_L
#undef PG8_BAR
#undef PG8_SCHED
#undef PG8_GOFF
#undef PG8_STAGE_A
}

template <class F> __device__ __forceinline__ void epi_rows(const f32x4 (&acc)[2][2][4][2], const Unit& u, int wr, int wc, int fr, int fq, F&& f) {
#pragma unroll
    for (int ai = 0; ai < 2; ++ai)
#pragma unroll
        for (int m = 0; m < 4; ++m) { const int row = u.pm * BM + ai * HALF + wr * 64 + m * 16 + fr;
#pragma unroll
            for (int bj = 0; bj < 2; ++bj) { const int col = u.pn * BM + bj * HALF + wc * 32 + 8 * fq; f(row, col, acc[ai][bj][m][0], acc[ai][bj][m][1]); } }
}
__device__ __forceinline__ u32x4 pack8(f32x4 a, f32x4 b) { u32x4 w; w.x = cvtpk(a[0], a[1]); w.y = cvtpk(a[2], a[3]); w.z = cvtpk(b[0], b[1]); w.w = cvtpk(b[2], b[3]); return w; }
__device__ __forceinline__ void unpack8f(u32x4 w, float* f) { f[0] = bflo(w.x); f[1] = bfhi(w.x); f[2] = bflo(w.y); f[3] = bfhi(w.y); f[4] = bflo(w.z); f[5] = bfhi(w.z); f[6] = bflo(w.w); f[7] = bfhi(w.w); }
__device__ __forceinline__ void split8(f32x4 v0, f32x4 v1, float* a) { a[0] = v0[0]; a[1] = v0[1]; a[2] = v0[2]; a[3] = v0[3]; a[4] = v1[0]; a[5] = v1[1]; a[6] = v1[2]; a[7] = v1[3]; }
__device__ __forceinline__ u32x4 pack8a(const float* o) { u32x4 w; w.x = cvtpk(o[0], o[1]); w.y = cvtpk(o[2], o[3]); w.z = cvtpk(o[4], o[5]); w.w = cvtpk(o[6], o[7]); return w; }

struct EpiBf16 {
    bf16_t* O; int ldc; const float* rs;
    __device__ __forceinline__ void operator()(const f32x4 (&acc)[2][2][4][2], const Unit& u, int wr, int wc, int fr, int fq) const {
        epi_rows(acc, u, wr, wc, fr, fq, [&](int row, int col, f32x4 v0, f32x4 v1) { const float s = rs ? rs[row] : 1.f; *(u32x4*)(O + (size_t)row * ldc + col) = pack8(v0 * s, v1 * s); });
    }
};
struct EpiBf16NT {
    bf16_t* O; int ldc;
    __device__ __forceinline__ void operator()(const f32x4 (&acc)[2][2][4][2], const Unit& u, int wr, int wc, int fr, int fq) const {
        epi_rows(acc, u, wr, wc, fr, fq, [&](int row, int col, f32x4 v0, f32x4 v1) { __builtin_nontemporal_store(pack8(v0, v1), (u32x4*)(O + (size_t)row * ldc + col)); });
    }
};
struct EpiF32 {
    float* O; int ldc;
    __device__ __forceinline__ void operator()(const f32x4 (&acc)[2][2][4][2], const Unit& u, int wr, int wc, int fr, int fq) const {
        epi_rows(acc, u, wr, wc, fr, fq, [&](int row, int col, f32x4 v0, f32x4 v1) { float* p = O + (size_t)row * ldc + col; *(f32x4*)p = v0; *(f32x4*)(p + 4) = v1; });
    }
};
struct EpiLogW {
    float* O; const float* w0;
    __device__ __forceinline__ void operator()(const f32x4 (&acc)[2][2][4][2], const Unit& u, int wr, int wc, int fr, int fq) const {
        epi_rows(acc, u, wr, wc, fr, fq, [&](int row, int col, f32x4 v0, f32x4 v1) { float a[8], o[8]; split8(v0, v1, a);
#pragma unroll
            for (int j = 0; j < 8; ++j) { const float x = -(w0[col + j] + a[j]); const float sp = fmaxf(x, 0.f) + __logf(1.f + __expf(-fabsf(x))); o[j] = -__expf(-sp - 0.5f); }
            float* p = O + (size_t)row * RW + col; *(f32x4*)p = (f32x4){o[0], o[1], o[2], o[3]}; *(f32x4*)(p + 4) = (f32x4){o[4], o[5], o[6], o[7]}; });
    }
};
struct EpiSigBias {
    bf16_t* O; const float* b;
    __device__ __forceinline__ void operator()(const f32x4 (&acc)[2][2][4][2], const Unit& u, int wr, int wc, int fr, int fq) const {
        epi_rows(acc, u, wr, wc, fr, fq, [&](int row, int col, f32x4 v0, f32x4 v1) { float a[8], o[8]; split8(v0, v1, a);
#pragma unroll
            for (int j = 0; j < 8; ++j) o[j] = sigmoidf_(b[col + j] + a[j]);
            *(u32x4*)(O + (size_t)row * RW + col) = pack8a(o); });
    }
};
template <bool ACCUM> struct EpiMerge {
    bf16_t* O; const bf16_t* gate;
    __device__ __forceinline__ void operator()(const f32x4 (&acc)[2][2][4][2], const Unit& u, int wr, int wc, int fr, int fq) const {
        epi_rows(acc, u, wr, wc, fr, fq, [&](int row, int col, f32x4 v0, f32x4 v1) { float a[8], gv[8], pv[8], o[8]; split8(v0, v1, a);
            unpack8f(*(const u32x4*)(gate + (size_t)row * IN_TOTAL + col), gv);
            if (ACCUM) unpack8f(*(const u32x4*)(O + (size_t)row * DM + col), pv);
#pragma unroll
            for (int j = 0; j < 8; ++j) { float r = sigmoidf_(gv[j]) * a[j]; if (ACCUM) r += pv[j]; o[j] = r; }
            *(u32x4*)(O + (size_t)row * DM + col) = pack8a(o); });
    }
};
struct EpiResid {
    bf16_t* O; const float* X; float* ssq;
    __device__ __forceinline__ void operator()(const f32x4 (&acc)[2][2][4][2], const Unit& u, int wr, int wc, int fr, int fq) const {
        epi_rows(acc, u, wr, wc, fr, fq, [&](int row, int col, f32x4 v0, f32x4 v1) { const size_t off = (size_t)row * DM + col; const f32x4 x0 = *(const f32x4*)(X + off), x1 = *(const f32x4*)(X + off + 4);
            const u32x4 w = pack8(x0 + v0, x1 + v1); *(u32x4*)(O + off) = w;
            float f[8]; unpack8f(w, f); float s = ((f[0] * f[0] + f[1] * f[1]) + (f[2] * f[2] + f[3] * f[3])) + ((f[4] * f[4] + f[5] * f[5]) + (f[6] * f[6] + f[7] * f[7]));
            s += __shfl_xor(s, 16); s += __shfl_xor(s, 32);
            if (fq == 0) (void)__hip_atomic_fetch_add(ssq + row, s, RLX_AGENT); });
    }
};
struct EpiBf16Ssq {
    bf16_t* O; int ldc; float* ssq;
    __device__ __forceinline__ void operator()(const f32x4 (&acc)[2][2][4][2], const Unit& u, int wr, int wc, int fr, int fq) const {
        epi_rows(acc, u, wr, wc, fr, fq, [&](int row, int col, f32x4 v0, f32x4 v1) { const u32x4 w = pack8(v0, v1); *(u32x4*)(O + (size_t)row * ldc + col) = w;
            float f[8]; unpack8f(w, f); float s = ((f[0] * f[0] + f[1] * f[1]) + (f[2] * f[2] + f[3] * f[3])) + ((f[4] * f[4] + f[5] * f[5]) + (f[6] * f[6] + f[7] * f[7]));
            s += __shfl_xor(s, 16); s += __shfl_xor(s, 32);
            if (fq == 0) (void)__hip_atomic_fetch_add(ssq + row, s, RLX_AGENT); });
    }
};
struct EpiF32Rs {
    float* O; int ldc; const float* ssq;
    __device__ __forceinline__ void operator()(const f32x4 (&acc)[2][2][4][2], const Unit& u, int wr, int wc, int fr, int fq) const {
        epi_rows(acc, u, wr, wc, fr, fq, [&](int row, int col, f32x4 v0, f32x4 v1) { const float rs = rsqrtf(ssq[row] * (1.f / DM) + EPS); float* p = O + (size_t)row * ldc + col; *(f32x4*)p = v0 * rs; *(f32x4*)(p + 4) = v1 * rs; });
    }
};
struct EpiSwiGLU {
    bf16_t* O; const int* rowtok; const float* ssq;
    __device__ __forceinline__ void operator()(const f32x4 (&acc)[2][2][4][2], const Unit& u, int wr, int wc, int fr, int fq) const {
#pragma unroll
        for (int ai = 0; ai < 2; ++ai)
#pragma unroll
            for (int m = 0; m < 4; ++m) { const int row = u.pm * BM + ai * HALF + wr * 64 + m * 16 + fr; const int col = (u.pn & 3) * 128 + wc * 32 + 8 * fq;
                int tk = __hip_atomic_load(rowtok + row, RLX_AGENT); if ((unsigned)tk >= (unsigned)T) tk = 0;
                const float rs = rsqrtf(ssq[tk] * (1.f / DM) + EPS);
                float gt[8], up[8], o[8]; split8(acc[ai][0][m][0], acc[ai][0][m][1], gt); split8(acc[ai][1][m][0], acc[ai][1][m][1], up);
#pragma unroll
                for (int j = 0; j < 8; ++j) { gt[j] *= rs; up[j] *= rs; }
#pragma unroll
                for (int j = 0; j < 8; ++j) o[j] = gt[j] * sigmoidf_(gt[j]) * up[j];
                *(u32x4*)(O + (size_t)row * DE + col) = pack8a(o); }
    }
};
struct EpiDown {
    bf16_t* O;
    __device__ __forceinline__ void operator()(const f32x4 (&acc)[2][2][4][2], const Unit& u, int wr, int wc, int fr, int fq) const {
#pragma unroll
        for (int ai = 0; ai < 2; ++ai)
#pragma unroll
            for (int m = 0; m < 4; ++m) { const int row = u.pm * BM + ai * HALF + wr * 64 + m * 16 + fr;
#pragma unroll
                for (int bj = 0; bj < 2; ++bj) { const int col = (u.pn & 7) * BM + bj * HALF + wc * 32 + 8 * fq;
                    *(u32x4*)(O + (size_t)row * DM + col) = pack8(acc[ai][bj][m][0], acc[ai][bj][m][1]); } }
    }
};
struct EpiPle {
    float* O; const bf16_t* X2; const bf16_t* P; const float* rstd; const float* rstd2; const float* gpost;
    __device__ __forceinline__ void operator()(const f32x4 (&acc)[2][2][4][2], const Unit& u, int wr, int wc, int fr, int fq) const {
        epi_rows(acc, u, wr, wc, fr, fq, [&](int row, int col, f32x4 v0, f32x4 v1) { const size_t off = (size_t)row * DM + col; float a[8], pv[8], xx[8], o[8]; split8(v0, v1, a);
            unpack8f(*(const u32x4*)(P + off), pv); unpack8f(*(const u32x4*)(X2 + off), xx); const float rs = rsqrtf(rstd[row] * (1.f / DM) + EPS), r2 = rstd2[row];
#pragma unroll
            for (int j = 0; j < 8; ++j) o[j] = xx[j] + sigmoidf_(a[j] * r2) * pv[j] * rs * gpost[col + j];
            *(f32x4*)(O + off) = (f32x4){o[0], o[1], o[2], o[3]}; *(f32x4*)(O + off + 4) = (f32x4){o[4], o[5], o[6], o[7]}; });
    }
};
}

namespace att {
constexpr int NW = 8, QBLK = 32, KVBLK = 64, QB = 256;
constexpr int SHM_V = 16384, SHM_K = KVBLK * 384;
constexpr int OFF_V = 0, OFF_K = 2 * SHM_V, OFF_WS = OFF_K + 2 * SHM_K;
constexpr int LDS_ATT = OFF_WS + NW * 64 * 4;
static_assert(LDS_ATT <= RING_BYTES, "attention LDS");
constexpr int QPITCH = NH * QKD, KVPITCH = NH * 256, KRPITCH = NH * ROPE, OPITCH = NH * VD;
constexpr float THR = 8.f;
#define SBAR() __builtin_amdgcn_sched_barrier(0)
__device__ __forceinline__ int v_st(int k, int c) { const int kk = (k & ~0xC) | ((k & 4) << 1) | ((k & 8) >> 1); return ((kk >> 3) * 4 + (c >> 5)) * 512 + ((kk & 7) * 32 + (c & 31)) * 2; }
__device__ __forceinline__ int v_rd_base(int lane) { return ((lane & 3) << 3) | (((lane >> 2) & 3) << 6) | (((lane >> 4) & 1) << 5) | (((lane >> 5) & 1) << 8); }
constexpr int v_rd_off(int d0, int ks, int half) { return d0 * 512 + ks * 4096 + half * 2048; }
__device__ __forceinline__ int crow(int r, int hi) { return (r & 3) + 8 * (r >> 2) + 4 * hi; }

template <int KB>
__device__ __forceinline__ void qkt(f32x16& p0, f32x16& p1, const LAS char* const* kbv, const bf16x8* qr) {
    p0 = (f32x16){0.f, 0.f, 0.f, 0.f, 0.f, 0.f, 0.f, 0.f, 0.f, 0.f, 0.f, 0.f, 0.f, 0.f, 0.f, 0.f}; p1 = p0;
#pragma unroll
    for (int d0 = 0; d0 < 12; ++d0) {
        const bf16x8 a0 = *(const LAS bf16x8*)(kbv[d0 & 3] + KB * SHM_K + (d0 >> 2) * 128);
        const bf16x8 a1 = *(const LAS bf16x8*)(kbv[d0 & 3] + KB * SHM_K + (d0 >> 2) * 128 + 32 * 384);
        p0 = __builtin_amdgcn_mfma_f32_32x32x16_bf16(a0, qr[d0], p0, 0, 0, 0);
        p1 = __builtin_amdgcn_mfma_f32_32x32x16_bf16(a1, qr[d0], p1, 0, 0, 0);
    }
}
__device__ __forceinline__ void mask_tile(f32x16& p0, f32x16& p1, int dq) {
    const float NEG = -__builtin_inff();
#pragma unroll
    for (int r = 0; r < 16; ++r) { const int c = (r & 3) + 8 * (r >> 2); if (c > dq) p0[r] = NEG; if (c + 32 > dq) p1[r] = NEG; }
}
__device__ __forceinline__ void softmax_tile(f32x16& p0, f32x16& p1, float& m_reg, float& l_reg, float& alpha, bf16x8& pa0, bf16x8& pa1, bf16x8& pa2, bf16x8& pa3) {
    float pmax = p0[0];
#pragma unroll
    for (int r = 1; r < 16; ++r) pmax = fmaxf(pmax, p0[r]);
#pragma unroll
    for (int r = 0; r < 16; ++r) pmax = fmaxf(pmax, p1[r]);
    { auto rr = __builtin_amdgcn_permlane32_swap(__float_as_uint(pmax), __float_as_uint(pmax), false, false); pmax = fmaxf(__uint_as_float(rr[0]), __uint_as_float(rr[1])); }
    float mn;
    if (__all(pmax - m_reg <= THR)) { mn = m_reg; alpha = 1.f; }
    else { mn = fmaxf(m_reg, pmax); alpha = __builtin_amdgcn_exp2f(m_reg - mn); m_reg = mn; }
    float ps = 0.f;
#pragma unroll
    for (int r = 0; r < 16; ++r) { p0[r] = __builtin_amdgcn_exp2f(p0[r] - mn); ps += p0[r]; }
#pragma unroll
    for (int r = 0; r < 16; ++r) { p1[r] = __builtin_amdgcn_exp2f(p1[r] - mn); ps += p1[r]; }
    { auto rr = __builtin_amdgcn_permlane32_swap(__float_as_uint(ps), __float_as_uint(ps), false, false); ps = __uint_as_float(rr[0]) + __uint_as_float(rr[1]); }
    l_reg = l_reg * alpha + ps;
#define PK4(P, B_, OUT) do { unsigned a0 = cvtpk(P[B_+0], P[B_+1]), a1 = cvtpk(P[B_+2], P[B_+3]); unsigned b0 = cvtpk(P[B_+4], P[B_+5]), b1 = cvtpk(P[B_+6], P[B_+7]); \
        auto r0 = __builtin_amdgcn_permlane32_swap(a0, b0, false, false); auto r1 = __builtin_amdgcn_permlane32_swap(a1, b1, false, false); \
        u32x4 w = {r0[0], r1[0], r0[1], r1[1]}; OUT = __builtin_bit_cast(bf16x8, w); } while (0)
    PK4(p0, 0, pa0); PK4(p0, 8, pa1); PK4(p1, 0, pa2); PK4(p1, 8, pa3);
#undef PK4
}
template <int VB>
__device__ __forceinline__ void pv_tile(f32x16* o, unsigned vb0, bf16x8 pa0, bf16x8 pa1, bf16x8 pa2, bf16x8 pa3) {
#define TRRD(dst, off) asm volatile("ds_read_b64_tr_b16 %0, %1 offset:%2" : "=&v"(dst) : "v"(vb0), "i"(off) : "memory")
#define PV_D0(d0) do { s16x4 l0, l1, l2, l3, h0, h1, h2, h3; constexpr int b_ = VB * SHM_V + v_rd_off(d0, 0, 0); \
        TRRD(l0, b_); TRRD(h0, b_ + 2048); TRRD(l1, b_ + 4096); TRRD(h1, b_ + 6144); TRRD(l2, b_ + 8192); TRRD(h2, b_ + 10240); TRRD(l3, b_ + 12288); TRRD(h3, b_ + 14336); \
        asm volatile("s_waitcnt lgkmcnt(0)" ::: "memory"); SBAR(); \
        o[d0] = __builtin_amdgcn_mfma_f32_32x32x16_bf16(pa0, (bf16x8){l0[0], l0[1], l0[2], l0[3], h0[0], h0[1], h0[2], h0[3]}, o[d0], 0, 0, 0); \
        o[d0] = __builtin_amdgcn_mfma_f32_32x32x16_bf16(pa1, (bf16x8){l1[0], l1[1], l1[2], l1[3], h1[0], h1[1], h1[2], h1[3]}, o[d0], 0, 0, 0); \
        o[d0] = __builtin_amdgcn_mfma_f32_32x32x16_bf16(pa2, (bf16x8){l2[0], l2[1], l2[2], l2[3], h2[0], h2[1], h2[2], h2[3]}, o[d0], 0, 0, 0); \
        o[d0] = __builtin_amdgcn_mfma_f32_32x32x16_bf16(pa3, (bf16x8){l3[0], l3[1], l3[2], l3[3], h3[0], h3[1], h3[2], h3[3]}, o[d0], 0, 0, 0); } while (0)
    PV_D0(0); PV_D0(1); PV_D0(2); PV_D0(3);
#undef PV_D0
#undef TRRD
}

__device__ __forceinline__ void attn_unit(int h, int qb, const bf16_t* Q, const bf16_t* K2, const bf16_t* KV, bf16_t* O, LAS char* lds, const float* gq, const float* tab) {
    const int tid = threadIdx.x, wid = __builtin_amdgcn_readfirstlane(tid >> 6), lane = tid & 63, r32 = lane & 31, hi = lane >> 5;
    const int NT = (qb + 1) * 4;
    const int qlo = qb * QB + wid * QBLK;
    LAS float* wsf = (LAS float*)(lds + OFF_WS) + wid * 64; LAS float* li_l = wsf; LAS float* al_l = wsf + 32;
    const char* baseK = (const char*)(K2 + h * QKD); const char* baseV = (const char*)(KV + h * 256 + 128);
    unsigned offK[3], offV[2];
#pragma unroll
    for (int i = 0; i < 3; ++i) { const int b = (wid + 8 * i) * 1024 + lane * 16, row = b / 384, cp = (b % 384) / 16, ch = (cp & ~7) | ((cp & 7) ^ ((row >> 1) & 7)); offK[i] = (unsigned)(row * QPITCH * 2 + ch * 16); }
#pragma unroll
    for (int i = 0; i < 2; ++i) { const int b = (wid + 8 * i) * 1024 + lane * 16, st = b >> 9, kk = (st >> 2) * 8 + ((b & 511) >> 6), c = (st & 3) * 32 + ((b & 63) >> 1);
        const int k = (kk & ~0xC) | ((kk & 4) << 1) | ((kk & 8) >> 1); offV[i] = (unsigned)(k * KVPITCH * 2 + c * 2); }
    const unsigned vb0 = (unsigned)(uintptr_t)(lds + OFF_V) + v_rd_base(lane);
    const LAS char* kbv[4];
#pragma unroll
    for (int dd = 0; dd < 4; ++dd) kbv[dd] = lds + OFF_K + r32 * 384 + (((2 * dd + hi) ^ ((r32 >> 1) & 7)) << 4);
    bf16x8 qr[12];
    {
      const bf16_t* qp = Q + (size_t)(qlo + r32) * QPITCH + h * QKD + hi * 8;
      u32x4 qw[12];
#pragma unroll
      for (int d0 = 0; d0 < 12; ++d0) qw[d0] = *(const u32x4*)(qp + d0 * 16);
      float ssq = 0.f;
#pragma unroll
      for (int d0 = 0; d0 < 12; ++d0) { const u32x4 w = qw[d0]; const float f[8] = {bflo(w.x), bfhi(w.x), bflo(w.y), bfhi(w.y), bflo(w.z), bfhi(w.z), bflo(w.w), bfhi(w.w)};
#pragma unroll
          for (int j = 0; j < 8; ++j) ssq += f[j] * f[j]; }
      { const auto r_ = __builtin_amdgcn_permlane32_swap(__builtin_bit_cast(unsigned, ssq), __builtin_bit_cast(unsigned, ssq), false, false); ssq = __builtin_bit_cast(float, (unsigned)r_[0]) + __builtin_bit_cast(float, (unsigned)r_[1]); }
      const float rq = rsqrtf(ssq * (1.f / QKD) + EPS) * (0.07216878364870322f * 1.4426950408889634f);
      const float* tb = tab + (size_t)(qlo + r32) * 64 + 8 * hi;
#pragma unroll
      for (int d0 = 0; d0 < 8; ++d0) { const u32x4 w = qw[d0]; const float* gp = gq + 16 * d0 + 8 * hi; const f32x4 g0 = *(const f32x4*)gp, g1 = *(const f32x4*)(gp + 4);
          u32x4 o; o.x = cvtpk(bflo(w.x) * rq * g0.x, bfhi(w.x) * rq * g0.y); o.y = cvtpk(bflo(w.y) * rq * g0.z, bfhi(w.y) * rq * g0.w); o.z = cvtpk(bflo(w.z) * rq * g1.x, bfhi(w.z) * rq * g1.y); o.w = cvtpk(bflo(w.w) * rq * g1.z, bfhi(w.w) * rq * g1.w);
          qr[d0] = __builtin_bit_cast(bf16x8, o); }
#pragma unroll
      for (int dd = 0; dd < 2; ++dd) { const u32x4 wa = qw[8 + dd], wb = qw[10 + dd];
          const float* ga = gq + 128 + 16 * dd + 8 * hi; const f32x4 ga0 = *(const f32x4*)ga, ga1 = *(const f32x4*)(ga + 4), gb0 = *(const f32x4*)(ga + 32), gb1 = *(const f32x4*)(ga + 36);
          const f32x4 c0 = *(const f32x4*)(tb + 16 * dd), c1 = *(const f32x4*)(tb + 16 * dd + 4), s0 = *(const f32x4*)(tb + 32 + 16 * dd), s1 = *(const f32x4*)(tb + 32 + 16 * dd + 4);
          const float fa[8] = {bflo(wa.x), bfhi(wa.x), bflo(wa.y), bfhi(wa.y), bflo(wa.z), bfhi(wa.z), bflo(wa.w), bfhi(wa.w)}, fb[8] = {bflo(wb.x), bfhi(wb.x), bflo(wb.y), bfhi(wb.y), bflo(wb.z), bfhi(wb.z), bflo(wb.w), bfhi(wb.w)};
          const float gA[8] = {ga0.x, ga0.y, ga0.z, ga0.w, ga1.x, ga1.y, ga1.z, ga1.w}, gB[8] = {gb0.x, gb0.y, gb0.z, gb0.w, gb1.x, gb1.y, gb1.z, gb1.w};
          const float cs[8] = {c0.x, c0.y, c0.z, c0.w, c1.x, c1.y, c1.z, c1.w}, sn[8] = {s0.x, s0.y, s0.z, s0.w, s1.x, s1.y, s1.z, s1.w};
          float oa[8], ob[8];
#pragma unroll
          for (int j = 0; j < 8; ++j) { const float a = fa[j] * rq * gA[j], b = fb[j] * rq * gB[j]; oa[j] = a * cs[j] - b * sn[j]; ob[j] = b * cs[j] + a * sn[j]; }
          u32x4 o; o.x = cvtpk(oa[0], oa[1]); o.y = cvtpk(oa[2], oa[3]); o.z = cvtpk(oa[4], oa[5]); o.w = cvtpk(oa[6], oa[7]); qr[8 + dd] = __builtin_bit_cast(bf16x8, o);
          o.x = cvtpk(ob[0], ob[1]); o.y = cvtpk(ob[2], ob[3]); o.z = cvtpk(ob[4], ob[5]); o.w = cvtpk(ob[6], ob[7]); qr[10 + dd] = __builtin_bit_cast(bf16x8, o); } }
#define SLOAD(t, bf) do { const char* bk_ = baseK + (size_t)(t) * (KVBLK * QPITCH * 2); const char* bv_ = baseV + (size_t)(t) * (KVBLK * KVPITCH * 2); \
        _Pragma("unroll") for (int i_ = 0; i_ < 3; ++i_) __builtin_amdgcn_global_load_lds((const unsigned*)(bk_ + offK[i_]), (LAS unsigned*)(lds + OFF_K + (bf) * SHM_K + (wid + 8 * i_) * 1024), 16, 0, 0); \
        _Pragma("unroll") for (int i_ = 0; i_ < 2; ++i_) __builtin_amdgcn_global_load_lds((const unsigned*)(bv_ + offV[i_]), (LAS unsigned*)(lds + OFF_V + (bf) * SHM_V + (wid + 8 * i_) * 1024), 16, 0, 0); } while (0)
    float m_reg = -1e30f, l_reg = 0.f;
    f32x16 o[4];
#pragma unroll
    for (int d = 0; d < 4; ++d) o[d] = (f32x16){0.f, 0.f, 0.f, 0.f, 0.f, 0.f, 0.f, 0.f, 0.f, 0.f, 0.f, 0.f, 0.f, 0.f, 0.f, 0.f};
#define STEP(t, BUF) do { const int kbase_ = (t) * KVBLK; if (kbase_ <= qlo + QBLK - 1) { f32x16 p0, p1; bf16x8 pa0, pa1, pa2, pa3; float alpha; \
        qkt<BUF>(p0, p1, kbv, qr); \
        if (kbase_ + KVBLK - 1 > qlo) mask_tile(p0, p1, qlo + r32 - kbase_ - 4 * hi); \
        softmax_tile(p0, p1, m_reg, l_reg, alpha, pa0, pa1, pa2, pa3); \
        if (__any(alpha < 1.f)) { if (hi == 0) al_l[r32] = alpha; asm volatile("s_waitcnt lgkmcnt(0)" ::: "memory"); \
            _Pragma("unroll") for (int r = 0; r < 16; ++r) { const float a_ = al_l[crow(r, hi)]; _Pragma("unroll") for (int d_ = 0; d_ < 4; ++d_) o[d_][r] *= a_; } } \
        SBAR(); pv_tile<BUF>(o, vb0, pa0, pa1, pa2, pa3); } } while (0)
    SLOAD(0, 0); VM_WAIT(); __syncthreads();
    for (int t = 0; t < NT; t += 2) {
        SLOAD(t + 1, 1);
        STEP(t, 0);
        VM_WAIT(); __syncthreads();
        if (t + 2 < NT) SLOAD(t + 2, 0);
        STEP(t + 1, 1);
        VM_WAIT(); __syncthreads();
    }
    if (hi == 0) li_l[r32] = l_reg;
    asm volatile("s_waitcnt lgkmcnt(0)" ::: "memory");
    int lane_e = lane; asm volatile("" : "+v"(lane_e));
    const int r32e = lane_e & 31, hie = lane_e >> 5;
    bf16_t* Ow = O + (size_t)qlo * OPITCH + h * VD;
#pragma unroll
    for (int r = 0; r < 16; ++r) { const int orow = crow(r, hie); const float rl = __builtin_amdgcn_rcpf(li_l[orow]);
#pragma unroll
        for (int d0 = 0; d0 < 4; ++d0) { const float v = o[d0][r] * rl; const float vn = __shfl_xor(v, 1);
            if ((r32e & 1) == 0) *(unsigned*)(Ow + (size_t)orow * OPITCH + d0 * 32 + r32e) = cvtpk(v, vn); } }
    __syncthreads();
#undef SLOAD
#undef STEP
}
#undef SBAR
}

struct Args {
    const float* in[36]; float* out; unsigned char* ws;
    float inv_freq[32];
    int ph_lo, ph_hi, li, pad;
};
struct Frame { LAS unsigned char* lds; int tid, lane, wave, G, gw, NGW; unsigned char* ws; };

enum { I_X = 0, I_P, I_POS, I_GMIX, I_WIN, I_GQA, I_WQB, I_GKVA, I_WKVB, I_GQH, I_GKH, I_MU, I_W0, I_W2, I_A0, I_A2, I_G2, I_KK, I_KA, I_RK, I_LNG, I_LNB,
       I_WBR, I_WOUT, I_GFFN, I_WGRP, I_BGRP, I_WEXP, I_BEXP, I_WEG, I_WEU, I_WED, I_GPLE, I_WPG, I_WPP, I_GPP };

__device__ __forceinline__ void transpose_item(const float* W, int ldw, int Kvalid, int k0, int n0, bf16_t* WT, size_t ldt, int drow0, const float* kscale, LAS float* scr, int lane) {
#pragma unroll 8
    for (int i = 0; i < 32; ++i) { const int kk = 2 * i + (lane >> 5); const int k = k0 + kk;
        float v = 0.f; if (k < Kvalid) { v = W[(size_t)k * ldw + n0 + (lane & 31)]; if (kscale) v *= kscale[k]; }
        scr[kk * 33 + (lane & 31)] = v; }
    LDS_WAIT(); asm volatile("" ::: "memory");
    const int c = lane & 7;
#pragma unroll
    for (int j = 0; j < 4; ++j) { const int n = (lane >> 3) + 8 * j; const LAS float* s = scr + (8 * c) * 33 + n;
        u32x4 o; o.x = pk2(s[0 * 33], s[1 * 33]); o.y = pk2(s[2 * 33], s[3 * 33]); o.z = pk2(s[4 * 33], s[5 * 33]); o.w = pk2(s[6 * 33], s[7 * 33]);
        *(u32x4*)(WT + (size_t)(drow0 + n) * ldt + k0 + 8 * c) = o; }
    LDS_WAIT(); asm volatile("" ::: "memory");
}
__device__ __forceinline__ void transpose_mat_item(const float* W, int Kvalid, int Kpad, int N, bf16_t* WT, const float* kscale, int it, LAS float* scr, int lane) {
    const int nblk = N / 32, kb = it / nblk, nb = it % nblk;
    transpose_item(W, N, Kvalid, 64 * kb, 32 * nb, WT, (size_t)Kpad, 32 * nb, kscale, scr, lane);
}
__device__ __forceinline__ void transpose64_item(const float* W, int ldw, int k0, int n0, bf16_t* WT, size_t ldt, int drow0, const float* kscale, LAS unsigned* scr, int lane) {
    const int kr = lane >> 4, c4 = lane & 15;
    f32x4 ra[8], rb[8];
#pragma unroll
    for (int i = 0; i < 8; ++i) { const float* p = W + (size_t)(k0 + 8 * i + 2 * kr) * ldw + n0 + 4 * c4; ra[i] = *(const f32x4*)p; rb[i] = *(const f32x4*)(p + ldw); }
    if (kscale) {
#pragma unroll
        for (int i = 0; i < 8; ++i) { const float s0 = kscale[k0 + 8 * i + 2 * kr], s1 = kscale[k0 + 8 * i + 2 * kr + 1]; ra[i] = ra[i] * s0; rb[i] = rb[i] * s1; } }
#pragma unroll
    for (int i = 0; i < 8; ++i)
#pragma unroll
        for (int e = 0; e < 4; ++e) { const int n = 4 * c4 + e; scr[n * 32 + ((4 * i + kr) ^ (4 * (c4 & 7)))] = cvtpk(ra[i][e], rb[i][e]); }
    LDS_WAIT(); asm volatile("" ::: "memory");
#pragma unroll
    for (int j = 0; j < 8; ++j) { const int id = lane + 64 * j, n = id >> 3, ch = id & 7;
        const u32x4 v = *(const LAS u32x4*)(scr + n * 32 + ((ch ^ ((n >> 2) & 7)) << 2));
        *(u32x4*)(WT + (size_t)(drow0 + n) * ldt + k0 + ch * 8) = v; }
    LDS_WAIT(); asm volatile("" ::: "memory");
}
__device__ __forceinline__ void transpose64_mat_item(const float* W, int K, int N, bf16_t* WT, const float* kscale, int it, LAS unsigned* scr, int lane) {
    const int nblk = N / 64, kb = it / nblk, nb = it % nblk;
    transpose64_item(W, N, 64 * kb, 64 * nb, WT, (size_t)K, 64 * nb, kscale, scr, lane);
}
__device__ __forceinline__ void norm_row_bf16(const float* xrow, const float* g, bf16_t* orow, int lane) {
    const f32x4* xr = (const f32x4*)xrow + lane; f32x4 v[8]; float s = 0.f;
#pragma unroll
    for (int j = 0; j < 8; ++j) { v[j] = xr[64 * j]; s += (v[j].x * v[j].x + v[j].y * v[j].y) + (v[j].z * v[j].z + v[j].w * v[j].w); }
    const float rstd = rsqrtf(wave_sum(s) * (1.f / DM) + EPS);
    u32x2* o8 = (u32x2*)orow + lane;
#pragma unroll
    for (int j = 0; j < 8; ++j) { const f32x4 gg = ((const f32x4*)g)[lane + 64 * j]; u32x2 w; w.x = cvtpk(v[j].x * rstd * gg.x, v[j].y * rstd * gg.y); w.y = cvtpk(v[j].z * rstd * gg.z, v[j].w * rstd * gg.w); o8[64 * j] = w; }
}
__device__ __forceinline__ void norm_row2_bf16(const float* xa, const float* xb, const float* g, bf16_t* oa, bf16_t* ob, int lane) {
    const f32x4* ra = (const f32x4*)xa + lane; const f32x4* rb = (const f32x4*)xb + lane; f32x4 va[8], vb[8]; float sa = 0.f, sb = 0.f;
#pragma unroll
    for (int j = 0; j < 8; ++j) { va[j] = ra[64 * j]; vb[j] = rb[64 * j]; }
#pragma unroll
    for (int j = 0; j < 8; ++j) { sa += (va[j].x * va[j].x + va[j].y * va[j].y) + (va[j].z * va[j].z + va[j].w * va[j].w); sb += (vb[j].x * vb[j].x + vb[j].y * vb[j].y) + (vb[j].z * vb[j].z + vb[j].w * vb[j].w); }
#pragma unroll
    for (int o = 1; o < 64; o <<= 1) { sa += __shfl_xor(sa, o); sb += __shfl_xor(sb, o); }
    const float rsa = rsqrtf(sa * (1.f / DM) + EPS), rsb = rsqrtf(sb * (1.f / DM) + EPS);
    u32x2* pa = (u32x2*)oa + lane; u32x2* pb = (u32x2*)ob + lane;
#pragma unroll
    for (int j = 0; j < 8; ++j) { const f32x4 gg = ((const f32x4*)g)[lane + 64 * j]; u32x2 w; w.x = cvtpk(va[j].x * rsa * gg.x, va[j].y * rsa * gg.y); w.y = cvtpk(va[j].z * rsa * gg.z, va[j].w * rsa * gg.w); pa[64 * j] = w;
        w.x = cvtpk(vb[j].x * rsb * gg.x, vb[j].y * rsb * gg.y); w.y = cvtpk(vb[j].z * rsb * gg.z, vb[j].w * rsb * gg.w); pb[64 * j] = w; }
}
__device__ __forceinline__ void norm_brow2_bf16(const bf16_t* xa, const bf16_t* xb, const float* g, bf16_t* oa, bf16_t* ob, int lane) {
    const u32x2* ra = (const u32x2*)xa + lane; const u32x2* rb = (const u32x2*)xb + lane; u32x2 wa[8], wb[8]; float sa = 0.f, sb = 0.f;
#pragma unroll
    for (int j = 0; j < 8; ++j) { wa[j] = ra[64 * j]; wb[j] = rb[64 * j]; }
#pragma unroll
    for (int j = 0; j < 8; ++j) { const float a0 = bflo(wa[j].x), a1 = bfhi(wa[j].x), a2 = bflo(wa[j].y), a3 = bfhi(wa[j].y), b0 = bflo(wb[j].x), b1 = bfhi(wb[j].x), b2 = bflo(wb[j].y), b3 = bfhi(wb[j].y);
        sa += (a0 * a0 + a1 * a1) + (a2 * a2 + a3 * a3); sb += (b0 * b0 + b1 * b1) + (b2 * b2 + b3 * b3); }
#pragma unroll
    for (int o = 1; o < 64; o <<= 1) { sa += __shfl_xor(sa, o); sb += __shfl_xor(sb, o); }
    const float rsa = rsqrtf(sa * (1.f / DM) + EPS), rsb = rsqrtf(sb * (1.f / DM) + EPS);
    u32x2* pa = (u32x2*)oa + lane; u32x2* pb = (u32x2*)ob + lane;
#pragma unroll
    for (int j = 0; j < 8; ++j) { const f32x4 gg = ((const f32x4*)g)[lane + 64 * j]; u32x2 w;
        w.x = cvtpk(bflo(wa[j].x) * rsa * gg.x, bfhi(wa[j].x) * rsa * gg.y); w.y = cvtpk(bflo(wa[j].y) * rsa * gg.z, bfhi(wa[j].y) * rsa * gg.w); pa[64 * j] = w;
        w.x = cvtpk(bflo(wb[j].x) * rsb * gg.x, bfhi(wb[j].x) * rsb * gg.y); w.y = cvtpk(bflo(wb[j].y) * rsb * gg.z, bfhi(wb[j].y) * rsb * gg.w); pb[64 * j] = w; }
}
__device__ __forceinline__ void unpack8(u32x4 w, float* f) { f[0] = bflo(w.x); f[1] = bfhi(w.x); f[2] = bflo(w.y); f[3] = bfhi(w.y); f[4] = bflo(w.z); f[5] = bfhi(w.z); f[6] = bflo(w.w); f[7] = bfhi(w.w); }

__device__ __forceinline__ float fmix_lo(float a, unsigned spk, float c) { float d; asm("v_fma_mix_f32 %0, %1, %2, %3 op_sel_hi:[0,1,0]" : "=v"(d) : "v"(a), "s"(spk), "v"(c)); return d; }
__device__ __forceinline__ float fmix_hi(float a, unsigned spk, float c) { float d; asm("v_fma_mix_f32 %0, %1, %2, %3 op_sel:[0,1,0] op_sel_hi:[0,1,0]" : "=v"(d) : "v"(a), "s"(spk), "v"(c)); return d; }
__device__ __forceinline__ float vmix_lo(float a, unsigned vpk, float c) { float d; asm("v_fma_mix_f32 %0, %1, %2, %3 op_sel_hi:[0,1,0]" : "=v"(d) : "v"(a), "v"(vpk), "v"(c)); return d; }
__device__ __forceinline__ float vmix_hi(float a, unsigned vpk, float c) { float d; asm("v_fma_mix_f32 %0, %1, %2, %3 op_sel:[0,1,0] op_sel_hi:[0,1,0]" : "=v"(d) : "v"(a), "v"(vpk), "v"(c)); return d; }
__device__ __forceinline__ float fmul_s(float a, unsigned sw) { float d; asm("v_mul_f32 %0, %1, %2" : "=v"(d) : "s"(sw), "v"(a)); return d; }
typedef unsigned u32x16 __attribute__((ext_vector_type(16)));
typedef const u32x16 __attribute__((address_space(4)))* c16p;
constexpr int R2_STEP = 1792, R2_WAVE_LDS = 16384, R2_PIECE = 4 * R2_STEP;
struct R2Stage { u32x2 zr, zrp, zk, zkp, zv, zvp, aa; f32x4 lw; };
struct R2Src { const bf16_t* proj; const bf16_t* AA; const float* LW; };
__device__ __forceinline__ void r2_load(R2Stage& st, const R2Src& S, int unit, int piece, int lane) {
    const int c = unit >> 4, hh = unit & 15, t = c * 64 + piece * 4 + (lane >> 4), ch = hh * 64 + 4 * (lane & 15);
    const bf16_t* row = S.proj + (size_t)t * IN_TOTAL + MLA_IN + ch; const bf16_t* prow = (t > 0) ? row - IN_TOTAL : row;
    st.zr = *(const u32x2*)row; st.zrp = *(const u32x2*)prow; st.zk = *(const u32x2*)(row + RW); st.zkp = *(const u32x2*)(prow + RW);
    st.aa = *(const u32x2*)(S.AA + (size_t)t * RW + ch); st.lw = *(const f32x4*)(S.LW + (size_t)t * RW + ch);
    st.zv = *(const u32x2*)(row + 2 * RW); st.zvp = *(const u32x2*)(prow + 2 * RW);
}
__device__ __forceinline__ void r2_bf4(u32x2 v, float* f) { f[0] = bflo(v.x); f[1] = bfhi(v.x); f[2] = bflo(v.y); f[3] = bfhi(v.y); }
typedef __bf16 bf16v2 __attribute__((ext_vector_type(2)));
__device__ __forceinline__ unsigned cvtpk_c(float lo, float hi) { return __builtin_bit_cast(unsigned, __builtin_convertvector((f32x2){lo, hi}, bf16v2)); }
__device__ __forceinline__ u32x2 r2_hilo_a(float x) { const unsigned h = cvtpk_c(x, 0.f); const float xh = __builtin_bit_cast(float, h << 16); const unsigned l = cvtpk_c(0.f, x - xh); return (u32x2){h | l, h}; }
__device__ __forceinline__ u32x2 r2_hilo_b(float y) { const unsigned h = cvtpk_c(y, y); const float yh = __builtin_bit_cast(float, h & 0xffff0000u); const unsigned l = cvtpk_c(y - yh, 0.f); return (u32x2){h, l}; }
__device__ __forceinline__ f32x16 r2_mfma(u32x4 a, u32x4 b, f32x16 c) { return __builtin_amdgcn_mfma_f32_32x32x16_bf16(__builtin_bit_cast(bf16x8, a), __builtin_bit_cast(bf16x8, b), c, 0, 0, 0); }
__device__ __forceinline__ u32x4 r2_aop(const LAS unsigned char* p, int dlt) { const u32x2 lo = *(const LAS u32x2*)p, hi = *(const LAS u32x2*)(p + dlt); return (u32x4){lo.x, lo.y, hi.x, hi.y}; }
__device__ __forceinline__ void r2_write(const R2Stage& st, LAS unsigned char* buf, const LAS float* cst, int lane, bool reset, bool last, bool first) {
    const int s_ = lane >> 4, cg = lane & 15;
    const f32x4 mur = *(const LAS f32x4*)(cst + 4 * cg), muk = *(const LAS f32x4*)(cst + 64 + 4 * cg), kkc = *(const LAS f32x4*)(cst + 128 + 4 * cg), kac = *(const LAS f32x4*)(cst + 192 + 4 * cg), muv = *(const LAS f32x4*)(cst + 256 + 4 * cg);
    float zr[4], zrp[4], zk[4], zkp[4], zv[4], zvp[4], aa[4]; r2_bf4(st.zr, zr); r2_bf4(st.zrp, zrp); r2_bf4(st.zk, zk); r2_bf4(st.zkp, zkp); r2_bf4(st.zv, zv); r2_bf4(st.zvp, zvp); r2_bf4(st.aa, aa);
    if (first && s_ == 0) {
#pragma unroll
        for (int j = 0; j < 4; ++j) { zrp[j] = 0.f; zkp[j] = 0.f; zvp[j] = 0.f; } }
    float r[4], k[4], kk[4], ss = 0.f;
#pragma unroll
    for (int j = 0; j < 4; ++j) { r[j] = zr[j] + (zrp[j] - zr[j]) * mur[j]; k[j] = zk[j] + (zkp[j] - zk[j]) * muk[j]; kk[j] = k[j] * kkc[j]; ss += kk[j] * kk[j]; }
    ss += __builtin_bit_cast(float, __builtin_amdgcn_update_dpp(0, __builtin_bit_cast(int, ss), 0xB1, 0xF, 0xF, true));
    ss += __builtin_bit_cast(float, __builtin_amdgcn_update_dpp(0, __builtin_bit_cast(int, ss), 0x4E, 0xF, 0xF, true));
    ss += __builtin_bit_cast(float, __builtin_amdgcn_update_dpp(0, __builtin_bit_cast(int, ss), 0x141, 0xF, 0xF, true));
    ss += __builtin_bit_cast(float, __builtin_amdgcn_update_dpp(0, __builtin_bit_cast(int, ss), 0x140, 0xF, 0xF, true));
    const float rn = rsqrtf(ss + 1e-12f);
    f32x4 cum = st.lw;
#pragma unroll
    for (int j = 0; j < 4; ++j) { const float t1 = __shfl_up(cum[j], 16); if (s_ >= 1) cum[j] += t1; }
#pragma unroll
    for (int j = 0; j < 4; ++j) { const float t2 = __shfl_up(cum[j], 32); if (s_ >= 2) cum[j] += t2; }
    LAS f32x4* cslot = (LAS f32x4*)((LAS unsigned char*)cst + 1536 + cg * 16);
    f32x4 carry = *cslot; if (reset) carry = (f32x4){0.f, 0.f, 0.f, 0.f};
    cum += carry;
    if (s_ == 3) *cslot = cum;
    f32x4 av, bv, kv, rv, wv;
#pragma unroll
    for (int j = 0; j < 4; ++j) { const float kn = kk[j] * rn, W = __expf(cum[j]), iW = __expf(-cum[j]), Wm = __expf(cum[j] - st.lw[j]);
        av[j] = -kn * Wm; bv[j] = kn * aa[j] * iW; kv[j] = k[j] * (1.f + (aa[j] - 1.f) * kac[j]) * iW; rv[j] = r[j] * W; wv[j] = W; }
    LAS unsigned char* d = buf + s_ * R2_STEP + cg * 16;
    *(LAS f32x4*)d = av; *(LAS f32x4*)(d + 768) = rv;
    if (last && s_ == 3) *(LAS f32x4*)((LAS unsigned char*)cst + 1280 + cg * 16) = wv;
    *(LAS f32x4*)(d + 1536) = (f32x4){zv[0] + (zvp[0] - zv[0]) * muv[0], zv[1] + (zvp[1] - zv[1]) * muv[1], zv[2] + (zvp[2] - zv[2]) * muv[2], zv[3] + (zvp[3] - zv[3]) * muv[3]};
    u32x4 b01, b23, k01, k23;
    { const u32x2 t0 = r2_hilo_a(bv[0]), t1 = r2_hilo_a(bv[1]), t2 = r2_hilo_a(bv[2]), t3 = r2_hilo_a(bv[3]); b01 = (u32x4){t0.x, t0.y, t1.x, t1.y}; b23 = (u32x4){t2.x, t2.y, t3.x, t3.y}; }
    { const u32x2 t0 = r2_hilo_a(kv[0]), t1 = r2_hilo_a(kv[1]), t2 = r2_hilo_a(kv[2]), t3 = r2_hilo_a(kv[3]); k01 = (u32x4){t0.x, t0.y, t1.x, t1.y}; k23 = (u32x4){t2.x, t2.y, t3.x, t3.y}; }
    LAS unsigned char* d2 = buf + s_ * R2_STEP + cg * 32;
    *(LAS u32x4*)(d2 + 256) = b01; *(LAS u32x4*)(d2 + 272) = b23; *(LAS u32x4*)(d2 + 1024) = k01; *(LAS u32x4*)(d2 + 1040) = k23;
}
__device__ __forceinline__ void swap32(float& x, float& y) {
    const auto r = __builtin_amdgcn_permlane32_swap(__builtin_bit_cast(unsigned, x), __builtin_bit_cast(unsigned, y), false, false);
    x = __builtin_bit_cast(float, (unsigned)r[0]); y = __builtin_bit_cast(float, (unsigned)r[1]); }
template <int VAR>
__device__ __forceinline__ void r2_wave(int gw, int NGW, int lane, LAS unsigned char* wl, const R2Src S, const float* mu, const float* kkp, const float* kap, float* YR, _Float16* QQ, bf16_t* PT, float* LL) {
    constexpr int NU = (T / 64) * RH, NP = 16;
    int unit = gw; if (unit >= NU) return;
    LAS float* cst = (LAS float*)(wl + 2 * R2_PIECE);
    { const int hc = (unit & 15) * 64 + lane; cst[lane] = mu[hc]; cst[64 + lane] = mu[RW + hc]; cst[128 + lane] = kkp[hc]; cst[192 + lane] = kap[hc]; cst[256 + lane] = mu[2 * RW + hc]; }
    asm volatile("s_waitcnt lgkmcnt(0)" ::: "memory");
    R2Stage st; r2_load(st, S, unit, 0, lane); r2_write(st, wl, cst, lane, true, false, unit < 16);
    int pcount = 0;
    for (; unit < NU; unit += NGW) {
        const int c = unit >> 4, hh = unit & 15;
        f32x16 X[4][2];
        int ln = lane; asm volatile("" : "+v"(ln));
        const int hf = ln >> 5, n = ln & 31;
#pragma unroll
        for (int blk = 0; blk < 4; ++blk)
#pragma unroll
            for (int jb = 0; jb < 2; ++jb)
#pragma unroll
                for (int i = 0; i < 16; ++i) X[blk][jb][i] = (blk < 2 && (32 * jb + 8 * (i >> 2) + 4 * hf + (i & 3)) == n + 32 * blk) ? 1.f : 0.f;
        const LAS unsigned char* rprev = wl + hf * 16 + 768;
        u32x4 Bt0 = (u32x4){0u, 0u, 0u, 0u}, Bt1 = Bt0, Bt2 = Bt0, Bt3 = Bt0;
        const int adl = (n == 31) ? -8 : 8;
        const LAS unsigned char* aprev = wl + 256 + hf * 768 + 256 + n * 8;
        for (int piece = 0; piece < NP; ++piece, ++pcount) {
            int nu = unit, np = piece + 1; if (np == NP) { np = 0; nu = unit + NGW; }
            const bool spare = nu >= NU;
            if (spare) { nu = unit; np = NP - 1; }
            r2_load(st, S, nu, np, lane);
            const LAS unsigned char* pb = wl + (pcount & 1) * R2_PIECE;
            auto step = [&](const int s4, const bool tail) __attribute__((always_inline)) {
                const int i = piece * 4 + s4;
                const LAS unsigned char* ps = pb + s4 * R2_STEP;
                const LAS f32x4* pa = (const LAS f32x4*)(ps + hf * 16);
                const LAS f32x4* pr = (const LAS f32x4*)rprev;
                const LAS unsigned char* ap0 = ps + 256 + hf * 768 + n * 8; const u32x4 A1p = r2_aop(aprev, adl); u32x4 A0; float vv;
                f32x2 sa[4], ya[4];
#pragma unroll
                for (int blk = 0; blk < 4; ++blk) { sa[blk] = (f32x2){0.f, 0.f}; ya[blk] = (f32x2){0.f, 0.f}; }
                f32x4 av = pa[0], rv = pr[0];
                __builtin_amdgcn_sched_barrier(0);
                if (!(VAR & 1)) {
                    X[0][1] = r2_mfma(A1p, Bt0, X[0][1]); X[1][1] = r2_mfma(A1p, Bt1, X[1][1]); X[2][1] = r2_mfma(A1p, Bt2, X[2][1]); X[3][1] = r2_mfma(A1p, Bt3, X[3][1]); }
#pragma unroll
                for (int g = 0; g < 8; ++g) { const int jb = g >> 2, q = g & 3;
                    f32x4 avn = av, rvn = rv; if (g < 7) { const int qi = 8 * ((g + 1) >> 2) + 2 * ((g + 1) & 3); avn = pa[qi]; rvn = pr[qi]; }
#pragma unroll
                    for (int h2 = 0; h2 < 2; ++h2) { const f32x2 a2 = h2 ? (f32x2){av.z, av.w} : (f32x2){av.x, av.y}, r2 = h2 ? (f32x2){rv.z, rv.w} : (f32x2){rv.x, rv.y};
#pragma unroll
                        for (int blk = 0; blk < 4; ++blk) { const f32x2 x = (f32x2){X[blk][jb][4 * q + 2 * h2], X[blk][jb][4 * q + 2 * h2 + 1]};
                            sa[blk] = x * a2 + sa[blk]; ya[blk] = x * r2 + ya[blk]; } }
                    if (g == 3) {
#pragma unroll
                        for (int k = 0; k < 4; ++k) { __builtin_amdgcn_sched_group_barrier(0x008, 1, 0); __builtin_amdgcn_sched_group_barrier(0x002, 16, 0); }
                        __builtin_amdgcn_sched_barrier(0); }
                    if (g == 5) { __builtin_amdgcn_sched_barrier(0); A0 = r2_aop(ap0, adl); vv = *(const LAS float*)(ps + 1536 + ln * 4); }
                    av = avn; rv = rvn; }
                float sh0 = sa[0].x + sa[0].y, sh1 = sa[1].x + sa[1].y, sz0 = sa[2].x + sa[2].y, sz1 = sa[3].x + sa[3].y;
                swap32(sh0, sh1); swap32(sz0, sz1);
                float hA = sh0 + sh1, hB = 0.f, zA = sz0 + sz1, zB = vv;
                swap32(hA, hB); swap32(zA, zB);
                { const u32x2 b0 = r2_hilo_b(hA), b1 = r2_hilo_b(hB), b2 = r2_hilo_b(zA), b3 = r2_hilo_b(zB);
                  Bt0.x = b0.x; Bt0.y = b0.y; Bt1.x = b1.x; Bt1.y = b1.y; Bt2.x = b2.x; Bt2.y = b2.y; Bt3.x = b3.x; Bt3.y = b3.y; }
                if (!(VAR & 3)) {
                    X[0][0] = r2_mfma(A0, Bt0, X[0][0]); X[1][0] = r2_mfma(A0, Bt1, X[1][0]); X[2][0] = r2_mfma(A0, Bt2, X[2][0]); X[3][0] = r2_mfma(A0, Bt3, X[3][0]); }
                float q0 = ya[0].x + ya[0].y, q1 = ya[1].x + ya[1].y, e0 = ya[2].x + ya[2].y, e1 = ya[3].x + ya[3].y;
                swap32(q0, q1); swap32(e0, e1);
                if (tail || i > 0) { *(_Float16*)((char*)QQ + (unsigned)(((unit * 64 + i - 1) * 64 + lane) * 2)) = (_Float16)(q0 + q1); *(float*)((char*)YR + (unsigned)(((c * 64 + i - 1) * RW + hh * 64 + lane) * 4)) = e0 + e1; }
                aprev = ap0 + 256;
                rprev = ps + hf * 16 + 768;
            };
#pragma unroll 1
            for (int s4 = 0; s4 < 3; ++s4) step(s4, false);
            step(3, true);
            r2_write(st, wl + ((pcount + 1) & 1) * R2_PIECE, cst, lane, np == 0, np == NP - 1 && !spare, np == 0 && nu < 16);
            asm volatile("s_waitcnt lgkmcnt(0)" ::: "memory");
        }
        { const u32x4 A1p = r2_aop(aprev, adl); X[0][1] = r2_mfma(A1p, Bt0, X[0][1]); X[1][1] = r2_mfma(A1p, Bt1, X[1][1]); X[2][1] = r2_mfma(A1p, Bt2, X[2][1]); X[3][1] = r2_mfma(A1p, Bt3, X[3][1]); }
        { const LAS f32x4* pr = (const LAS f32x4*)rprev; const LAS f32x4* pw = (const LAS f32x4*)((const LAS unsigned char*)cst + 1280 + hf * 16);
            f32x2 ya[4];
#pragma unroll
            for (int blk = 0; blk < 4; ++blk) ya[blk] = (f32x2){0.f, 0.f};
#pragma unroll
            for (int g = 0; g < 8; ++g) { const int jb = g >> 2, q = g & 3; const f32x4 rv = pr[8 * jb + 2 * q];
                const f32x4 wv = pw[8 * jb + 2 * q];
#pragma unroll
                for (int blk = 0; blk < 4; ++blk) {
                    ya[blk] = (f32x2){X[blk][jb][4 * q], X[blk][jb][4 * q + 1]} * (f32x2){rv.x, rv.y} + ya[blk]; ya[blk] = (f32x2){X[blk][jb][4 * q + 2], X[blk][jb][4 * q + 3]} * (f32x2){rv.z, rv.w} + ya[blk];
#pragma unroll
                    for (int e = 0; e < 4; ++e) X[blk][jb][4 * q + e] *= wv[e]; } }
            float q0 = ya[0].x + ya[0].y, q1 = ya[1].x + ya[1].y, e0 = ya[2].x + ya[2].y, e1 = ya[3].x + ya[3].y;
            swap32(q0, q1); swap32(e0, e1);
            { QQ[((size_t)unit * 64 + 63) * 64 + lane] = (_Float16)(q0 + q1); YR[(size_t)(c * 64 + 63) * RW + hh * 64 + lane] = e0 + e1; } }
#pragma unroll
        for (int rs = 0; rs < 2; ++rs) { const int row = n + 32 * rs;
#pragma unroll
            for (int jb = 0; jb < 2; ++jb)
#pragma unroll
                for (int q = 0; q < 4; ++q) { const int col = 32 * jb + 8 * q + 4 * hf;
                    *(f32x4*)(LL + ((((size_t)unit * 4 + (row >> 4)) * 4 + (col >> 4)) * 64 + (row & 15) + 16 * ((col >> 2) & 3)) * 4) = (f32x4){X[2 + rs][jb][4 * q], X[2 + rs][jb][4 * q + 1], X[2 + rs][jb][4 * q + 2], X[2 + rs][jb][4 * q + 3]};
#pragma unroll
                    for (int e = 0; e < 4; ++e) { const int cl = col + e;
                        PT[((((size_t)unit * 4 + (cl >> 4)) * 2 + (row >> 5)) * 64 + (cl & 15) + 16 * ((row >> 2) & 3)) * 8 + ((row >> 4) & 1) * 4 + (row & 3)] = (bf16_t)f2bf(X[rs][jb][4 * q + e]); } }
        }
    }
}
template <int MODE>
__device__ __forceinline__ void chain_run(int hh, int grp, int w, int lane, LAS unsigned char* ring, const bf16_t* PT, const float* LL, bf16_t* PGF, float* LGF, float* GSF, float* SC) {
    constexpr int NS = 16, RD = 4, RS = 5, SLOT = 24576;
    const int vq = w & 3, fr = lane & 15, q4 = lane >> 4;
    const bf16_t* Asrc = (MODE == 1) ? PGF : PT; const float* Lsrc = (MODE == 1) ? LGF : LL;
#define CH_UNIT(s_) ((MODE == 1) ? (size_t)(hh * 16 + (s_)) : (size_t)((grp * 16 + (s_)) * RH + hh))
#define CH_ISSUE(s_) do { const int ss_ = (s_) < NS ? (s_) : NS - 1; const size_t u_ = CH_UNIT(ss_); LAS unsigned char* sl_ = ring + ((s_) % RS) * SLOT; \
        __builtin_amdgcn_global_load_lds((const unsigned*)(Asrc + (u_ * 8 + w) * 512 + lane * 8), (LAS unsigned*)(sl_ + w * 1024), 16, 0, 0); \
        __builtin_amdgcn_global_load_lds((const unsigned*)(Lsrc + (u_ * 16 + w) * 256 + lane * 4), (LAS unsigned*)(sl_ + (8 + w) * 1024), 16, 0, 0); \
        __builtin_amdgcn_global_load_lds((const unsigned*)(Lsrc + (u_ * 16 + 8 + w) * 256 + lane * 4), (LAS unsigned*)(sl_ + (16 + w) * 1024), 16, 0, 0); } while (0)
    CH_ISSUE(0); CH_ISSUE(1); CH_ISSUE(2); CH_ISSUE(3);
    f32x4 Xs[4];
    const bool prun = (MODE == 0) && (w >= 4);
    const bool comp = (MODE == 0) || (w < 4);
#pragma unroll
    for (int tn = 0; tn < 4; ++tn) { Xs[tn] = (f32x4){0.f, 0.f, 0.f, 0.f};
        if (MODE == 0) { if (prun) {
#pragma unroll
            for (int rg = 0; rg < 4; ++rg) Xs[tn][rg] = (16 * tn + 4 * q4 + rg == 16 * vq + fr) ? 1.f : 0.f; } }
        if (MODE == 2) { if (w < 4) Xs[tn] = *(const f32x4*)(GSF + (((size_t)(hh * 16 + grp) * 4 + vq) * 4 + tn) * 256 + lane * 4); } }
    asm volatile("s_waitcnt vmcnt(9)" ::: "memory"); __builtin_amdgcn_s_barrier();
    for (int st = 0; st < NS; ++st) {
        CH_ISSUE(st + RD);
        if (comp) {
            const LAS unsigned char* sl = ring + (st % RS) * SLOT;
            if (MODE == 1) { float* gp = GSF + (((size_t)(hh * 16 + st) * 4 + vq) * 4) * 256 + lane * 4;
#pragma unroll
                for (int tn = 0; tn < 4; ++tn) *(f32x4*)(gp + tn * 256) = Xs[tn]; }
            if (MODE == 2) { float* scp = SC + (((size_t)((grp * 16 + st) * RH + hh) * 4 + vq) * 4) * 256 + lane * 4;
#pragma unroll
                for (int tn = 0; tn < 4; ++tn) *(f32x4*)(scp + tn * 256) = Xs[tn]; }
            bf16x8 Bh[2], Bl[2];
#pragma unroll
            for (int s_ = 0; s_ < 2; ++s_) { unsigned hw[4], lw_[4];
#pragma unroll
                for (int e = 0; e < 4; ++e) { const f32x4 xv = Xs[2 * s_ + (e >> 1)]; const float x0 = xv[2 * (e & 1)], x1 = xv[2 * (e & 1) + 1];
                    const unsigned hp = cvtpk(x0, x1); hw[e] = hp; lw_[e] = cvtpk(x0 - bflo(hp), x1 - bfhi(hp)); }
                Bh[s_] = __builtin_bit_cast(bf16x8, (u32x4){hw[0], hw[1], hw[2], hw[3]}); Bl[s_] = __builtin_bit_cast(bf16x8, (u32x4){lw_[0], lw_[1], lw_[2], lw_[3]}); }
#pragma unroll
            for (int tm = 0; tm < 4; ++tm) { f32x4 acc = (f32x4){0.f, 0.f, 0.f, 0.f};
                if (!prun) acc = *(const LAS f32x4*)(sl + (8 + vq * 4 + tm) * 1024 + lane * 16);
#pragma unroll
                for (int s_ = 0; s_ < 2; ++s_) { const bf16x8 Af = *(const LAS bf16x8*)(sl + (tm * 2 + s_) * 1024 + lane * 16);
                    acc = __builtin_amdgcn_mfma_f32_16x16x32_bf16(Af, Bh[s_], acc, 0, 0, 0); acc = __builtin_amdgcn_mfma_f32_16x16x32_bf16(Af, Bl[s_], acc, 0, 0, 0); }
                Xs[tm] = acc; }
        }
        if (MODE != 0 && w < 4) asm volatile("s_waitcnt vmcnt(25) lgkmcnt(0)" ::: "memory"); else asm volatile("s_waitcnt vmcnt(9) lgkmcnt(0)" ::: "memory");
        __builtin_amdgcn_s_barrier();
    }
    asm volatile("s_waitcnt vmcnt(0)" ::: "memory");
    if (MODE == 0) {
        if (!prun) { float* lp = LGF + (((size_t)(hh * 16 + grp) * 4 + vq) * 4) * 256 + lane * 4;
#pragma unroll
            for (int tn = 0; tn < 4; ++tn) *(f32x4*)(lp + tn * 256) = Xs[tn]; }
        else { bf16_t* pp = PGF + (size_t)(hh * 16 + grp) * 4096;
#pragma unroll
            for (int tn = 0; tn < 4; ++tn)
#pragma unroll
                for (int rg = 0; rg < 4; ++rg) pp[(((tn * 2 + (vq >> 1)) * 64) + (4 * q4 + rg) + 16 * ((fr >> 2) & 3)) * 8 + (vq & 1) * 4 + (fr & 3)] = (bf16_t)f2bf(Xs[tn][rg]); }
    }
#undef CH_UNIT
#undef CH_ISSUE
}
struct TItem { const float* W; int ldw, k0, n0; bf16_t* WT; size_t ldt; int drow0; const float* ks; };
__device__ __forceinline__ void t64_load(const TItem& t, f32x4 (&ra)[8], f32x4 (&rb)[8], int lane) {
    const int kr = lane >> 4, c4 = lane & 15;
#pragma unroll
    for (int i = 0; i < 8; ++i) { const float* p = t.W + (size_t)(t.k0 + 8 * i + 2 * kr) * t.ldw + t.n0 + 4 * c4; ra[i] = __builtin_nontemporal_load((const f32x4*)p); rb[i] = __builtin_nontemporal_load((const f32x4*)(p + t.ldw)); }
}
__device__ __forceinline__ void t64_finish(const TItem& t, const f32x4 (&ra)[8], const f32x4 (&rb)[8], LAS unsigned* scr, int lane) {
    const int kr = lane >> 4, c4 = lane & 15;
#pragma unroll
    for (int i = 0; i < 8; ++i) { float s0 = 1.f, s1 = 1.f; if (t.ks) { const f32x2 sv = *(const f32x2*)(t.ks + t.k0 + 8 * i + 2 * kr); s0 = sv.x; s1 = sv.y; }
#pragma unroll
        for (int e = 0; e < 4; ++e) { const int n = 4 * c4 + e; scr[n * 32 + ((4 * i + kr) ^ (4 * (c4 & 7)))] = cvtpk(ra[i][e] * s0, rb[i][e] * s1); } }
    LDS_WAIT(); asm volatile("" ::: "memory");
#pragma unroll
    for (int j = 0; j < 8; ++j) { const int id = lane + 64 * j, n = id >> 3, ch = id & 7;
        const u32x4 v = *(const LAS u32x4*)(scr + n * 32 + ((ch ^ ((n >> 2) & 7)) << 2));
        __builtin_nontemporal_store(v, (u32x4*)(t.WT + (size_t)(t.drow0 + n) * t.ldt + t.k0 + ch * 8)); }
    LDS_WAIT(); asm volatile("" ::: "memory");
}
constexpr int CONV_EARLY = 16 * 256;
constexpr int CONV_RT = 64 * 768 - 10240;
constexpr int CONV_SPLIT = CONV_EARLY + 32 * 768 - 2048;
__device__ __forceinline__ void expert_conv_item(int it, const float* weg, const float* weu, const float* wed, bf16_t* wgu_e, bf16_t* wd_e, LAS unsigned* scr64, int lane, const float* gffn_) {
    constexpr int C_G = (DM / 64) * (DE / 64);
    const int e = it / (3 * C_G); int r = it % (3 * C_G);
    if (r < 2 * C_G) { const int up = r >= C_G; if (up) r -= C_G; const int nblk = DE / 64, kb = r / nblk, nb = r % nblk, n0 = 64 * nb;
        transpose64_item((up ? weu : weg) + (size_t)e * DM * DE, DE, 64 * kb, n0, wgu_e, (size_t)DM, (n0 >> 7) * 256 + up * 128 + (n0 & 127), gffn_, scr64, lane); }
    else { r -= 2 * C_G; transpose64_mat_item(wed + (size_t)e * DE * DM, DE, DM, wd_e, nullptr, r, scr64, lane); }
}
__device__ __forceinline__ TItem expert_item(int it, const float* weg, const float* weu, const float* wed, GAS unsigned char* wsl, const float* gffn) {
    constexpr int C_G = (DM / 64) * (DE / 64);
    int e, r;
    if (it < CONV_EARLY) { e = 48 + it / C_G; r = 2 * C_G + it % C_G; }
    else { const int j = it - CONV_EARLY; if (j < 48 * 3 * C_G) { e = j / (3 * C_G); r = j % (3 * C_G); } else { const int q = j - 48 * 3 * C_G; e = 48 + q / (2 * C_G); r = q % (2 * C_G); } }
    TItem t;
    bf16_t* wgu_e = (bf16_t*)(wsl + (e < WGU_SPLIT ? WS_WGU_A + (size_t)e * (4 * MiB) : WS_WGU_B + (size_t)(e - WGU_SPLIT) * (4 * MiB))); bf16_t* wd_e = (bf16_t*)(wsl + WS_WD + (size_t)e * (2 * MiB));
    if (r < 2 * C_G) { const int up = r >= C_G; if (up) r -= C_G; const int nblk = DE / 64, kb = r / nblk, nb = r % nblk, n0 = 64 * nb;
        t.W = (up ? weu : weg) + (size_t)e * DM * DE; t.ldw = DE; t.k0 = 64 * kb; t.n0 = n0; t.WT = wgu_e; t.ldt = DM; t.drow0 = (n0 >> 7) * 256 + up * 128 + (n0 & 127); t.ks = gffn; }
    else { r -= 2 * C_G; const int nblk = DM / 64, kb = r / nblk, nb = r % nblk;
        t.W = wed + (size_t)e * DE * DM; t.ldw = DM; t.k0 = 64 * kb; t.n0 = 64 * nb; t.WT = wd_e; t.ldt = DE; t.drow0 = 64 * nb; t.ks = nullptr; }
    return t;
}
__device__ __forceinline__ void expert_conv_stream(int it0, int end, int stride, const float* weg, const float* weu, const float* wed, GAS unsigned char* wsl, LAS unsigned* scr64, int lane, const float* gffn) {
    if (it0 >= end) return;
    f32x4 a0[8], b0[8], a1[8], b1[8];
    TItem c0 = expert_item(it0, weg, weu, wed, wsl, gffn); t64_load(c0, a0, b0, lane);
    for (int it = it0; it < end; it += 2 * stride) {
        const int i1 = it + stride, i2 = it + 2 * stride;
        TItem c1 = c0; if (i1 < end) { c1 = expert_item(i1, weg, weu, wed, wsl, gffn); t64_load(c1, a1, b1, lane); }
        t64_finish(c0, a0, b0, scr64, lane);
        if (i1 < end) { if (i2 < end) { c0 = expert_item(i2, weg, weu, wed, wsl, gffn); t64_load(c0, a0, b0, lane); }
            t64_finish(c1, a1, b1, scr64, lane); }
    }
}
enum { PH_PRO = 0, PH_G1, PH_E1, PH_G2, PH_QKF, PH_ATT, PH_R2, PH_R3, PH_R3B, PH_R3C, PH_R4, PH_RO, PH_BR, PH_OUT, PH_E3, PH_RT, PH_SCAT, PH_GU, PH_DN, PH_E4, PH_PLE, N_PHASES };
__global__ void __launch_bounds__(NWAVES * 64, 2) mega(Args args) {
    extern __shared__ __attribute__((aligned(16))) unsigned char lds_raw[];
    Frame F; F.lds = (LAS unsigned char*)lds_raw; F.tid = threadIdx.x; F.lane = F.tid & 63; F.wave = __builtin_amdgcn_readfirstlane(F.tid >> 6);
    F.G = gridDim.x; F.gw = blockIdx.x * NWAVES + F.wave; F.NGW = F.G * NWAVES; F.ws = args.ws;
    unsigned char* ws = args.ws;
    gu32* ctl = (gu32*)(ws + WS_CTL);
    volatile LAS unsigned* MISC = (volatile LAS unsigned*)(F.lds + MISC_OFF);
    if (F.tid < 64) MISC[F.tid] = 0u;
    __syncthreads();
#if MK_ONE_LAUNCH
    XcdBarrier bar = xcd_barrier_post((unsigned*)ctl + CW_BAR + args.li * XCD_BAR_WORDS, MISC + 8);
#define GRID_BAR() xcd_barrier(bar)
#else
#define GRID_BAR() do {} while (0)
#endif
    const int lo = args.ph_lo, hi = args.ph_hi;
#ifndef PHASE_MASK
#define PHASE_MASK 0xFFFFFFFFu
#endif
#define IN(k) (((PHASE_MASK >> (k)) & 1u) && lo <= (k) && (k) < hi)
#ifndef PROBE_PH
#define PROBE_PH -1
#endif
#ifndef PROBE_N
#define PROBE_N 2
#endif
#define PHASE(k) if (IN(k))
#define SEAM(k) do { if (IN(k) && IN((k) + 1)) GRID_BAR(); } while (0)
    const int lane = F.lane, gw = F.gw, NGW = F.NGW;
#define WIN ((bf16_t*)(wsl + WS_WIN))
#define WQB ((bf16_t*)(wsl + WS_WQB))
#define WKVB ((bf16_t*)(wsl + WS_WKVB))
#define W2T ((bf16_t*)(wsl + WS_W2T))
#define A2T ((bf16_t*)(wsl + WS_A2T))
#define G2T ((bf16_t*)(wsl + WS_G2T))
#define WBR ((bf16_t*)(wsl + WS_WBR))
#define WOUT ((bf16_t*)(wsl + WS_WOUT))
#define WRT ((bf16_t*)(wsl + WS_WRT))
#define WPG ((bf16_t*)(wsl + WS_WPG))
#define WPP ((bf16_t*)(wsl + WS_WPP))
#define HB ((bf16_t*)(wsl + WS_HB))
#define PB ((bf16_t*)(wsl + WS_PB))
#define TAB ((float*)(wsl + WS_TAB))
#define PROJ ((bf16_t*)(wsl + WS_PROJ))
#define QB_ ((bf16_t*)(wsl + WS_Q))
#define KVB ((bf16_t*)(wsl + WS_KV))
#define K2B ((bf16_t*)(wsl + WS_KR))
#define OA ((bf16_t*)(wsl + WS_OA))
#define OB ((bf16_t*)(wsl + WS_OB))
#define LW ((float*)(wsl + WS_LW))
#define AA ((bf16_t*)(wsl + WS_AA))
#define GG ((bf16_t*)(wsl + WS_GG))
#define TW ((bf16_t*)(wsl + WS_TW))
#define ZA ((bf16_t*)(wsl + WS_ZA))
#define SG ((bf16_t*)(wsl + WS_SG))
#define MERGED ((bf16_t*)(wsl + WS_MERGED))
#define YR ((float*)(wsl + WS_YR))
#define WGU_E(e) ((bf16_t*)(wsl + ((e) < WGU_SPLIT ? WS_WGU_A + (size_t)(e) * (4 * MiB) : WS_WGU_B + (size_t)((e) - WGU_SPLIT) * (4 * MiB))))
#define WD_E(e) ((bf16_t*)(wsl + WS_WD + (size_t)(e) * (2 * MiB)))
#define RSTD2 ((float*)(wsl + WS_SMALL + SM_RSTD2))
#define ACT ((bf16_t*)(wsl + WS_ACT))
#define YB ((bf16_t*)(wsl + WS_Y))
#define LOGITS ((float*)(wsl + WS_LOGITS))
#define PLEB ((bf16_t*)(wsl + WS_PLE))
#define RSTDQ ((float*)(wsl + WS_SMALL + SM_RSTDQ))
#define RSTDKV ((float*)(wsl + WS_SMALL + SM_RSTDKV))
#define RSTDPLE ((float*)(wsl + WS_SMALL + SM_RSTDPLE))
#define TOKE ((int*)(wsl + WS_SMALL + SM_TOKE))
#define TOKP ((int*)(wsl + WS_SMALL + SM_TOKP))
#define TOKW ((float*)(wsl + WS_SMALL + SM_TOKW))
#define ROWTOK ((int*)(wsl + WS_SMALL + SM_ROWTOK))
#define X1B ((bf16_t*)(wsl + WS_X1B))
#define SSQP ((float*)(wsl + WS_CTL) + 81920)
#define SSQ1 ((float*)(wsl + WS_CTL) + 65536)
#define X2B ((bf16_t*)(wsl + WS_X2B))
#define CNT ((unsigned*)((gu32*)(wsl + WS_CTL)) + CW_CNT)
    GAS unsigned char* wsl = (GAS unsigned char*)args.ws;
    const float* X = args.in[I_X]; float* OUT = args.out;
    LAS float* scr = (LAS float*)(F.lds + F.wave * 16384);

    PHASE(PH_PRO) { GAS unsigned char* wsl = (GAS unsigned char*)args.ws; asm volatile("" : "+s"(wsl)); int lane_l = F.tid & 63; asm volatile("" : "+v"(lane_l)); const int lane = lane_l;
        constexpr int C_IN = (DM / 64) * (IN_TOTAL / 64);
        LAS unsigned* scr64 = (LAS unsigned*)scr;
        for (int it = gw; it < C_IN; it += NGW) transpose64_mat_item(args.in[I_WIN], DM, IN_TOTAL, WIN, nullptr, it, scr64, lane);
        for (int m = gw; m < T; m += 2 * NGW) norm_row2_bf16(X + (size_t)m * DM, X + (size_t)(m + NGW) * DM, args.in[I_GMIX], HB + (size_t)m * DM, HB + (size_t)(m + NGW) * DM, lane);
    }
    SEAM(PH_PRO);
    PHASE(PH_G1) { GAS unsigned char* wsl = (GAS unsigned char*)args.ws; asm volatile("" : "+s"(wsl)); int lane_l = F.tid & 63; asm volatile("" : "+v"(lane_l)); const int lane = lane_l;
        { pg8::Gemm g{HB, WIN, DM, DM, DM, nullptr}; pg8::StaticOrder S; S.init(T, IN_TOTAL, F.G, (int)blockIdx.x);
          pg8::EpiBf16NT E{PROJ, IN_TOTAL};
          pg8::gemm_phase<pg8::EpiBf16NT, pg8::StaticOrder, false>(F.lds, g, S, E); }
        __syncthreads();
        const int nwg_ = (T / 256) * (IN_TOTAL / 256), short0 = nwg_ % F.G;
        const int li = (short0 == 0) ? (int)blockIdx.x : (int)blockIdx.x - short0, nl = (short0 == 0) ? F.G : F.G - short0;
        if (li >= 0) {
            constexpr int C_QB = (QL / 64) * (1536 / 64), C_KVB = (KVL / 64) * (2048 / 64), C_W2 = 2 * (RW / 32), C_G2 = (GLORA / 64) * (RW / 64);
            constexpr int C_BR = (1024 / 64) * (DM / 64), C_SQ = (DM / 64) * (DM / 64), C_PP = (PLE / 64) * (DM / 64), C_EX = (DM / 64) * (NE / 64);
            constexpr int NIT = C_QB + C_KVB + 2 * C_W2 + C_G2 + 2 * C_BR + 2 * C_SQ + C_PP + C_EX;
            LAS unsigned* scr64 = (LAS unsigned*)scr;
            const int lw_ = li * NWAVES + F.wave, nlw = nl * NWAVES, lt = li * 512 + F.tid, nlt = nl * 512;
            for (int it = lw_; it < NIT; it += nlw) {
                int r = it;
                if (r < C_QB) { transpose64_mat_item(args.in[I_WQB], QL, 1536, WQB, args.in[I_GQA], r, scr64, lane); continue; } r -= C_QB;
                if (r < C_KVB) { transpose64_mat_item(args.in[I_WKVB], KVL, 2048, WKVB, args.in[I_GKVA], r, scr64, lane); continue; } r -= C_KVB;
                if (r < C_W2) { transpose_mat_item(args.in[I_W2], DLORA, 128, RW, W2T, nullptr, r, scr, lane); continue; } r -= C_W2;
                if (r < C_W2) { transpose_mat_item(args.in[I_A2], ALORA, 128, RW, A2T, nullptr, r, scr, lane); continue; } r -= C_W2;
                if (r < C_G2) { transpose64_mat_item(args.in[I_G2], GLORA, RW, G2T, nullptr, r, scr64, lane); continue; } r -= C_G2;
                if (r < C_BR) { transpose64_mat_item(args.in[I_WBR], 1024, DM, WBR, nullptr, r, scr64, lane); continue; } r -= C_BR;
                if (r < C_BR) { transpose64_mat_item(args.in[I_WBR] + (size_t)1024 * DM, 1024, DM, WBR + (size_t)DM * 1024, nullptr, r, scr64, lane); continue; } r -= C_BR;
                if (r < C_SQ) { transpose64_mat_item(args.in[I_WOUT], DM, DM, WOUT, nullptr, r, scr64, lane); continue; } r -= C_SQ;
                if (r < C_SQ) { transpose64_mat_item(args.in[I_WPG], DM, DM, WPG, args.in[I_GPLE], r, scr64, lane); continue; } r -= C_SQ;
                if (r < C_PP) { transpose64_mat_item(args.in[I_WPP], PLE, DM, WPP, nullptr, r, scr64, lane); continue; } r -= C_PP;
                transpose64_item(args.in[I_WEXP], NE, 64 * r, 0, WRT, (size_t)DM, 8, args.in[I_GFFN], scr64, lane);
            }
            for (int i = lt; i < NROUTE * DM; i += nlt) { const int n = i / DM, k = i % DM;
                if (n < NG) WRT[i] = (bf16_t)f2bf(args.in[I_WGRP][(size_t)k * NG + n] * args.in[I_GFFN][k]); else if (n >= NG + NE) WRT[i] = 0; }
            for (int i = lt; i < T * PLE / 4; i += nlt) { const f32x4 v = ((const f32x4*)args.in[I_P])[i]; u32x2 w; w.x = cvtpk(v.x, v.y); w.y = cvtpk(v.z, v.w); ((u32x2*)PB)[i] = w; }
            for (int i = lt; i < T * 32; i += nlt) { const int t = i >> 5, j = i & 31;
                const float a = (float)((const int*)args.in[I_POS])[t] * args.inv_freq[j];
                const double rev = (double)a * 0.15915494309189535; const float fr = (float)(rev - rint(rev));
                TAB[(size_t)t * 64 + j] = __builtin_amdgcn_cosf(fr); TAB[(size_t)t * 64 + 32 + j] = __builtin_amdgcn_sinf(fr); }
            expert_conv_stream(lw_, CONV_EARLY, nlw, args.in[I_WEG], args.in[I_WEU], args.in[I_WED], wsl, scr64, lane, args.in[I_GFFN]);
        }
    }
    SEAM(PH_G1);
    PHASE(PH_E1) { GAS unsigned char* wsl = (GAS unsigned char*)args.ws; asm volatile("" : "+s"(wsl)); int lane_l = F.tid & 63; asm volatile("" : "+v"(lane_l)); const int lane = lane_l;
        const float* mu = args.in[I_MU];
        for (int t = gw; t < T; t += NGW) {
            const bf16_t* row = PROJ + (size_t)t * IN_TOTAL;
            float f[8]; unpack8(*(const u32x4*)(row + lane * 8), f); float s = 0.f;
#pragma unroll
            for (int j = 0; j < 8; ++j) s += f[j] * f[j];
            s = wave_sum(s); if (lane == 0) RSTDQ[t] = rsqrtf(s * (1.f / QL) + EPS);
            unpack8(*(const u32x4*)(row + QL + lane * 8), f); s = 0.f;
#pragma unroll
            for (int j = 0; j < 8; ++j) s += f[j] * f[j];
            s = wave_sum(s); if (lane == 0) RSTDKV[t] = rsqrtf(s * (1.f / KVL) + EPS);
            if (lane < 56) {
                const int e0 = lane * 8; float z[8], zp[8], o[8];
                unpack8(*(const u32x4*)(row + MLA_IN + 3 * RW + e0), z);
                if (t > 0) unpack8(*(const u32x4*)(row - IN_TOTAL + MLA_IN + 3 * RW + e0), zp); else {
#pragma unroll
                    for (int j = 0; j < 8; ++j) zp[j] = 0.f; }
#pragma unroll
                for (int j = 0; j < 8; ++j) { const float m = z[j] + (zp[j] - z[j]) * mu[3 * RW + e0 + j]; o[j] = lane < 12 ? tanhf(m) : (lane < 24 ? m : sigmoidf_(m)); }
                u32x4 w; w.x = cvtpk(o[0], o[1]); w.y = cvtpk(o[2], o[3]); w.z = cvtpk(o[4], o[5]); w.w = cvtpk(o[6], o[7]);
                if (lane < 12) *(u32x4*)(TW + (size_t)t * 128 + e0) = w; else if (lane < 24) *(u32x4*)(ZA + (size_t)t * 128 + (e0 - 96)) = w; else *(u32x4*)(SG + (size_t)t * 256 + (e0 - 192)) = w;
            } else { const u32x4 z = {0u, 0u, 0u, 0u};
                if (lane < 60) *(u32x4*)(TW + (size_t)t * 128 + 96 + (lane - 56) * 8) = z; else *(u32x4*)(ZA + (size_t)t * 128 + 96 + (lane - 60) * 8) = z; }
        }
    }
    SEAM(PH_E1);
    PHASE(PH_G2) { GAS unsigned char* wsl = (GAS unsigned char*)args.ws; asm volatile("" : "+s"(wsl));
        { pg8::Gemm g{PROJ, WQB, IN_TOTAL, QL, QL, nullptr}; pg8::StaticOrder S; S.init(T, 1536, F.G, (int)blockIdx.x); pg8::EpiBf16 E{QB_, 1536, RSTDQ};
          pg8::gemm_phase<pg8::EpiBf16, pg8::StaticOrder, false>(F.lds, g, S, E); }
        { pg8::Gemm g{PROJ + QL, WKVB, IN_TOTAL, KVL, KVL, nullptr}; pg8::StaticOrder S; S.init(T, 2048, F.G, (int)blockIdx.x); pg8::EpiBf16 E{KVB, 2048, RSTDKV};
          pg8::gemm_phase<pg8::EpiBf16, pg8::StaticOrder, false>(F.lds, g, S, E); }
        { pg8::Gemm g{TW, W2T, 128, 128, 128, nullptr}; pg8::StaticOrder S; S.init(T, RW, F.G, (int)blockIdx.x); pg8::EpiLogW E{LW, args.in[I_W0]};
          pg8::gemm_phase<pg8::EpiLogW, pg8::StaticOrder, false>(F.lds, g, S, E); }
        { pg8::Gemm g{ZA, A2T, 128, 128, 128, nullptr}; pg8::StaticOrder S; S.init(T, RW, F.G, (int)blockIdx.x); pg8::EpiSigBias E{AA, args.in[I_A0]};
          pg8::gemm_phase<pg8::EpiSigBias, pg8::StaticOrder, false>(F.lds, g, S, E); }
        { pg8::Gemm g{SG, G2T, 256, 256, 256, nullptr}; pg8::StaticOrder S; S.init(T, RW, F.G, (int)blockIdx.x); pg8::EpiBf16 E{GG, RW, nullptr};
          pg8::gemm_phase<pg8::EpiBf16, pg8::StaticOrder, false>(F.lds, g, S, E); }
    }
    SEAM(PH_G2);
    PHASE(PH_QKF) { GAS unsigned char* wsl = (GAS unsigned char*)args.ws; asm volatile("" : "+s"(wsl)); int lane_l = F.tid & 63; asm volatile("" : "+v"(lane_l)); const int lane = lane_l;
        const float* gk = args.in[I_GKH];
        const int hh = lane >> 3, sub = lane & 7, jr = sub & 3;
        float gk0[8], gk1[8], gk2[8];
#pragma unroll
        for (int j = 0; j < 8; ++j) { gk0[j] = gk[sub * 8 + j]; gk1[j] = gk[64 + sub * 8 + j]; gk2[j] = gk[128 + sub * 8 + j]; }
        for (int t = gw; t < T; t += NGW) {
            const bf16_t* kp = KVB + (size_t)t * 2048 + hh * 256 + sub * 8;
            const u32x4 k0w = *(const u32x4*)kp, k1w = *(const u32x4*)(kp + 64), k2w = *(const u32x4*)(PROJ + (size_t)t * IN_TOTAL + QL + KVL + sub * 8);
            const float* tab = TAB + (size_t)t * 64 + jr * 8; float cs[8], sn[8];
#pragma unroll
            for (int q = 0; q < 2; ++q) { const f32x4 c4 = *(const f32x4*)(tab + 4 * q), s4 = *(const f32x4*)(tab + 32 + 4 * q); cs[4 * q] = c4.x; cs[4 * q + 1] = c4.y; cs[4 * q + 2] = c4.z; cs[4 * q + 3] = c4.w; sn[4 * q] = s4.x; sn[4 * q + 1] = s4.y; sn[4 * q + 2] = s4.z; sn[4 * q + 3] = s4.w; }
            float k0[8], k1[8], k2[8];
            unpack8(k0w, k0); unpack8(k1w, k1); unpack8(k2w, k2);
            float sk = 0.f;
#pragma unroll
            for (int j = 0; j < 8; ++j) sk += k0[j] * k0[j] + k1[j] * k1[j] + k2[j] * k2[j];
            sk += __shfl_xor(sk, 1); sk += __shfl_xor(sk, 2); sk += __shfl_xor(sk, 4);
            const float rk = rsqrtf(sk * (1.f / QKD) + EPS);
            float ok2[8];
#pragma unroll
            for (int j = 0; j < 8; ++j) { k0[j] *= rk * gk0[j]; k1[j] *= rk * gk1[j]; k2[j] *= rk * gk2[j]; }
#pragma unroll
            for (int j = 0; j < 8; ++j) { const float ko = __shfl_xor(k2[j], 4); ok2[j] = (sub < 4) ? k2[j] * cs[j] - ko * sn[j] : k2[j] * cs[j] + ko * sn[j]; }
            u32x4 w; bf16_t* ko_ = K2B + (size_t)t * 1536 + hh * QKD + sub * 8;
            w.x = cvtpk(k0[0], k0[1]); w.y = cvtpk(k0[2], k0[3]); w.z = cvtpk(k0[4], k0[5]); w.w = cvtpk(k0[6], k0[7]); *(u32x4*)ko_ = w;
            w.x = cvtpk(k1[0], k1[1]); w.y = cvtpk(k1[2], k1[3]); w.z = cvtpk(k1[4], k1[5]); w.w = cvtpk(k1[6], k1[7]); *(u32x4*)(ko_ + 64) = w;
            w.x = cvtpk(ok2[0], ok2[1]); w.y = cvtpk(ok2[2], ok2[3]); w.z = cvtpk(ok2[4], ok2[5]); w.w = cvtpk(ok2[6], ok2[7]); *(u32x4*)(ko_ + 128) = w;
        }
    }
    SEAM(PH_QKF);
    PHASE(PH_ATT) { GAS unsigned char* wsl = (GAS unsigned char*)args.ws; asm volatile("" : "+s"(wsl));
        if (F.wave >= 4) __builtin_amdgcn_s_setprio(1);
        for (int L = blockIdx.x; L < 256; L += F.G) { const int h = L & 7, x = L >> 3;
            for (int pass = 0; pass < 2; ++pass) att::attn_unit(h, pass ? x : 63 - x, QB_, K2B, KVB, OA, (LAS char*)F.lds, args.in[I_GQH], TAB); }
        __builtin_amdgcn_s_setprio(0);
    }
    SEAM(PH_ATT);
    #define PRM ((_Float16*)(wsl + WS_Q))
#define VM ((bf16_t*)(wsl + WS_OB))
#define PT ((bf16_t*)(wsl + WS_PT))
#define LL ((float*)(wsl + WS_HB))
#define QQ ((_Float16*)(wsl + WS_OB))
#define SC ((float*)(wsl + WS_MERGED))
    typedef _Float16 h2_t __attribute__((ext_vector_type(2)));
#define H2F(w_, hi_) ((float)__builtin_bit_cast(h2_t, (unsigned)(w_))[hi_])
#define FMIX(a_, spk_, hi_, c_) ((hi_) ? fmix_hi(a_, spk_, c_) : fmix_lo(a_, spk_, c_))
    PHASE(PH_R2) { GAS unsigned char* wsl = (GAS unsigned char*)args.ws; asm volatile("" : "+s"(wsl)); int lane_l = F.tid & 63; asm volatile("" : "+v"(lane_l)); const int lane = lane_l;
        asm volatile("s_waitcnt vmcnt(0) lgkmcnt(0)" ::: "memory"); __syncthreads();
        { const R2Src S2{PROJ, AA, LW};
#ifdef PROBE_VAR
          if (args.li == 1) r2_wave<PROBE_VAR>(gw, NGW, lane, F.lds + F.wave * R2_WAVE_LDS, S2, args.in[I_MU], args.in[I_KK], args.in[I_KA], YR, QQ, PT, LL); else
#endif
          r2_wave<0>(gw, NGW, lane, F.lds + F.wave * R2_WAVE_LDS, S2, args.in[I_MU], args.in[I_KK], args.in[I_KA], YR, QQ, PT, LL); }
    }
    SEAM(PH_R2);
#define PGF ((bf16_t*)(wsl + WS_TW))
#define LGF ((float*)(wsl + WS_TW + 2 * MiB))
#define GSF ((float*)(wsl + WS_TW + 6 * MiB))
#define R3_PHASE(MODE) do { GAS unsigned char* wsl = (GAS unsigned char*)args.ws; asm volatile("" : "+s"(wsl)); int lane_l = F.tid & 63; asm volatile("" : "+v"(lane_l)); const int lane = lane_l; \
        const int nwg_ = (MODE) == 1 ? RH : RH * 16; \
        if ((int)blockIdx.x < nwg_) { chain_run<MODE>((MODE) == 1 ? (int)blockIdx.x : ((int)blockIdx.x & 15), (MODE) == 1 ? 0 : ((int)blockIdx.x >> 4), F.wave, lane, F.lds, PT, LL, PGF, LGF, GSF, SC); } \
        __syncthreads(); } while (0)
    PHASE(PH_R3) { R3_PHASE(0); }
    SEAM(PH_R3);
    PHASE(PH_R3B) { R3_PHASE(1); }
    SEAM(PH_R3B);
    PHASE(PH_R3C) { R3_PHASE(2); }
    SEAM(PH_R3C);
#undef R3_PHASE

    PHASE(PH_R4) { GAS unsigned char* wsl = (GAS unsigned char*)args.ws; asm volatile("" : "+s"(wsl)); int lane_l = F.tid & 63; asm volatile("" : "+v"(lane_l)); const int lane = lane_l;
        typedef _Float16 f16x8 __attribute__((ext_vector_type(8))); typedef _Float16 f16x2 __attribute__((ext_vector_type(2)));
        constexpr int NU = (T / 64) * RH;
        const int n31 = lane & 31, kg = lane >> 5;
        LAS float* yl = (LAS float*)(F.lds + F.wave * 16384);
        const float* mu = args.in[I_MU];
        bf16_t* OB2 = (bf16_t*)(wsl + WS_HB);
        for (int unit = gw; unit < NU; unit += NGW) {
            const int c = unit >> 4, hh = unit & 15;
            float* yb = YR + (size_t)(c * 64 + 4 * kg) * RW + hh * 64 + n31;
            f32x16 acc[2][2];
#pragma unroll
            for (int tr = 0; tr < 2; ++tr)
#pragma unroll
                for (int tc = 0; tc < 2; ++tc)
#pragma unroll
                    for (int v = 0; v < 16; ++v) acc[tr][tc][v] = yb[(size_t)(32 * tr + 8 * (v >> 2) + (v & 3)) * RW + 32 * tc];
            f16x8 Bh[2][4], Bl[2][4];
#pragma unroll
            for (int tc = 0; tc < 2; ++tc) { const int ch = n31 + 32 * tc;
#pragma unroll
                for (int ks = 0; ks < 4; ++ks) {
                    const float* p = SC + ((((size_t)unit * 4 + (ch >> 4)) * 4 + ks) * 256) + ((ch & 15) + 32 * kg) * 4;
                    const f32x4 s0 = *(const f32x4*)p, s1 = *(const f32x4*)(p + 64);
                    const float sv[8] = {s0.x, s0.y, s0.z, s0.w, s1.x, s1.y, s1.z, s1.w};
                    f16x8 h, l;
#pragma unroll
                    for (int e = 0; e < 8; e += 2) { const f16x2 hp = __builtin_bit_cast(f16x2, __builtin_amdgcn_cvt_pkrtz(sv[e], sv[e + 1]));
                        const f16x2 lp = __builtin_bit_cast(f16x2, __builtin_amdgcn_cvt_pkrtz(sv[e] - (float)hp[0], sv[e + 1] - (float)hp[1]));
                        h[e] = hp[0]; h[e + 1] = hp[1]; l[e] = lp[0]; l[e + 1] = lp[1]; }
                    Bh[tc][ks] = h; Bl[tc][ks] = l; } }
#pragma unroll
            for (int tr = 0; tr < 2; ++tr)
#pragma unroll
                for (int ks = 0; ks < 4; ++ks) { const f16x8 A = *(const f16x8*)(QQ + (size_t)unit * 4096 + (n31 + 32 * tr) * 64 + 16 * ks + 8 * kg);
#pragma unroll
                    for (int tc = 0; tc < 2; ++tc) { acc[tr][tc] = __builtin_amdgcn_mfma_f32_32x32x16_f16(A, Bh[tc][ks], acc[tr][tc], 0, 0, 0); acc[tr][tc] = __builtin_amdgcn_mfma_f32_32x32x16_f16(A, Bl[tc][ks], acc[tr][tc], 0, 0, 0); } }
#pragma unroll
            for (int tr = 0; tr < 2; ++tr) {
#pragma unroll
                for (int tc = 0; tc < 2; ++tc)
#pragma unroll
                    for (int v = 0; v < 16; ++v) yl[(8 * (v >> 2) + 4 * kg + (v & 3)) * 68 + 32 * tc + n31] = (tr == 0) ? acc[0][tc][v] : acc[1][tc][v];
                const int t = c * 64 + 32 * tr + n31, e0 = hh * 64 + 32 * kg;
                const bf16_t* row = PROJ + (size_t)t * IN_TOTAL + MLA_IN + e0; const bf16_t* prow = (t > 0) ? row - IN_TOTAL : row; const bool tz = (t == 0);
                float y[32]; float s1 = 0.f, sb = 0.f;
#pragma unroll
                for (int q = 0; q < 4; ++q) { const int eq = e0 + 8 * q; float z[8], zp[8], av[8], cm[8], ck[8];
                    { const f32x4 y0 = *(const LAS f32x4*)(yl + n31 * 68 + 32 * kg + 8 * q), y1 = *(const LAS f32x4*)(yl + n31 * 68 + 32 * kg + 8 * q + 4);
                      y[8 * q] = y0.x; y[8 * q + 1] = y0.y; y[8 * q + 2] = y0.z; y[8 * q + 3] = y0.w; y[8 * q + 4] = y1.x; y[8 * q + 5] = y1.y; y[8 * q + 6] = y1.z; y[8 * q + 7] = y1.w; }
                    unpack8(*(const u32x4*)(AA + (size_t)t * RW + eq), av);
                    float r[8];
                    unpack8(*(const u32x4*)(row + 8 * q), z); unpack8(*(const u32x4*)(prow + 8 * q), zp);
                    { const f32x4 m0 = *(const f32x4*)(mu + eq), m1 = *(const f32x4*)(mu + eq + 4); cm[0] = m0.x; cm[1] = m0.y; cm[2] = m0.z; cm[3] = m0.w; cm[4] = m1.x; cm[5] = m1.y; cm[6] = m1.z; cm[7] = m1.w; }
#pragma unroll
                    for (int j = 0; j < 8; ++j) { const float p = tz ? 0.f : zp[j]; r[j] = z[j] + (p - z[j]) * cm[j]; }
                    unpack8(*(const u32x4*)(row + RW + 8 * q), z); unpack8(*(const u32x4*)(prow + RW + 8 * q), zp);
                    { const f32x4 m0 = *(const f32x4*)(mu + RW + eq), m1 = *(const f32x4*)(mu + RW + eq + 4); cm[0] = m0.x; cm[1] = m0.y; cm[2] = m0.z; cm[3] = m0.w; cm[4] = m1.x; cm[5] = m1.y; cm[6] = m1.z; cm[7] = m1.w; }
                    { const f32x4 k0 = *(const f32x4*)(args.in[I_KA] + eq), k1 = *(const f32x4*)(args.in[I_KA] + eq + 4); ck[0] = k0.x; ck[1] = k0.y; ck[2] = k0.z; ck[3] = k0.w; ck[4] = k1.x; ck[5] = k1.y; ck[6] = k1.z; ck[7] = k1.w; }
                    const f32x4 rk0 = *(const f32x4*)(args.in[I_RK] + eq), rk1 = *(const f32x4*)(args.in[I_RK] + eq + 4); const float rkk[8] = {rk0.x, rk0.y, rk0.z, rk0.w, rk1.x, rk1.y, rk1.z, rk1.w};
#pragma unroll
                    for (int j = 0; j < 8; ++j) { const float p = tz ? 0.f : zp[j]; const float kx = z[j] + (p - z[j]) * cm[j]; const float km = kx * (1.f + (av[j] - 1.f) * ck[j]);
                        s1 += y[8 * q + j]; sb += r[j] * km * rkk[j]; } }
                { float a_ = s1, b_ = s1; swap32(a_, b_); s1 = a_ + b_; float c_ = sb, d_ = sb; swap32(c_, d_); sb = c_ + d_; }
                const float mean = s1 * (1.f / 64.f); float s2 = 0.f;
#pragma unroll
                for (int j = 0; j < 32; ++j) { const float d = y[j] - mean; s2 += d * d; }
                { float a_ = s2, b_ = s2; swap32(a_, b_); s2 = a_ + b_; }
                const float rstd = rsqrtf(s2 * (1.f / 64.f) + LN_EPS);
#pragma unroll
                for (int q = 0; q < 4; ++q) { const int eq = e0 + 8 * q; float o[8], vs[8], gs[8];
                    { float z[8], zp[8]; unpack8(*(const u32x4*)(row + 2 * RW + 8 * q), z); unpack8(*(const u32x4*)(prow + 2 * RW + 8 * q), zp);
                      const f32x4 m0 = *(const f32x4*)(mu + 2 * RW + eq), m1 = *(const f32x4*)(mu + 2 * RW + eq + 4); const float cm[8] = {m0.x, m0.y, m0.z, m0.w, m1.x, m1.y, m1.z, m1.w};
#pragma unroll
                      for (int j = 0; j < 8; ++j) { const float p = tz ? 0.f : zp[j]; vs[j] = z[j] + (p - z[j]) * cm[j]; } }
                    unpack8(*(const u32x4*)(GG + (size_t)t * RW + eq), gs);
                    const f32x4 g0 = *(const f32x4*)(args.in[I_LNG] + eq), g1 = *(const f32x4*)(args.in[I_LNG] + eq + 4), b0 = *(const f32x4*)(args.in[I_LNB] + eq), b1 = *(const f32x4*)(args.in[I_LNB] + eq + 4);
                    const float lg[8] = {g0.x, g0.y, g0.z, g0.w, g1.x, g1.y, g1.z, g1.w}, lb[8] = {b0.x, b0.y, b0.z, b0.w, b1.x, b1.y, b1.z, b1.w};
#pragma unroll
                    for (int j = 0; j < 8; ++j) o[j] = ((y[8 * q + j] - mean) * rstd * lg[j] + lb[j] + sb * vs[j]) * gs[j];
                    u32x4 w; w.x = cvtpk(o[0], o[1]); w.y = cvtpk(o[2], o[3]); w.z = cvtpk(o[4], o[5]); w.w = cvtpk(o[6], o[7]);
                    *(u32x4*)(OB2 + (size_t)t * RW + eq) = w; }
            }
        }
    }
    SEAM(PH_RO);
    PHASE(PH_BR) { GAS unsigned char* wsl = (GAS unsigned char*)args.ws; asm volatile("" : "+s"(wsl));
        const bool conv_first = (((int)blockIdx.x >> 3) & 1) != 0;
#define BR_CONV() do { int lane_c = F.tid & 63; asm volatile("" : "+v"(lane_c)); LAS unsigned* scr64 = (LAS unsigned*)scr; \
            expert_conv_stream(CONV_EARLY + gw, CONV_SPLIT, NGW, args.in[I_WEG], args.in[I_WEU], args.in[I_WED], wsl, scr64, lane_c, args.in[I_GFFN]); \
            __syncthreads(); } while (0)
        if (conv_first) BR_CONV();
        { pg8::Gemm g{OA, WBR, 1024, 1024, 1024, nullptr}; pg8::StaticOrder S; S.init(T, DM, F.G, (int)blockIdx.x); pg8::EpiMerge<false> E{MERGED, PROJ + MLA_IN + RWKV_IN};
          pg8::gemm_phase<pg8::EpiMerge<false>, pg8::StaticOrder, false>(F.lds, g, S, E); }
        { pg8::Gemm g{(const bf16_t*)(wsl + WS_HB), WBR + (size_t)DM * 1024, 1024, 1024, 1024, nullptr}; pg8::StaticOrder S; S.init(T, DM, F.G, (int)blockIdx.x); pg8::EpiMerge<true> E{MERGED, PROJ + MLA_IN + RWKV_IN + DM};
          pg8::gemm_phase<pg8::EpiMerge<true>, pg8::StaticOrder, false>(F.lds, g, S, E); }
        __syncthreads();
        if (!conv_first) BR_CONV();
#undef BR_CONV
    }
    SEAM(PH_BR);
    PHASE(PH_OUT) { GAS unsigned char* wsl = (GAS unsigned char*)args.ws; asm volatile("" : "+s"(wsl));
        const bool conv_first = (((int)blockIdx.x >> 3) & 1) != 0;
#define OUT_CONV() do { int lane_c = F.tid & 63; asm volatile("" : "+v"(lane_c)); LAS unsigned* scr64 = (LAS unsigned*)scr; \
            expert_conv_stream(CONV_SPLIT + gw, (F.G >= 2 * (T / 256)) ? CONV_RT : NE * 768, NGW, args.in[I_WEG], args.in[I_WEU], args.in[I_WED], wsl, scr64, lane_c, args.in[I_GFFN]); \
            __syncthreads(); } while (0)
        if (conv_first) OUT_CONV();
        { pg8::Gemm g{MERGED, WOUT, DM, DM, DM, nullptr}; pg8::StaticOrder S; S.init(T, DM, F.G, (int)blockIdx.x); pg8::EpiResid E{X1B, X, SSQ1};
          pg8::gemm_phase<pg8::EpiResid, pg8::StaticOrder, false>(F.lds, g, S, E); }
        __syncthreads();
        if (!conv_first) OUT_CONV();
#undef OUT_CONV
    }
    SEAM(PH_OUT);
    PHASE(PH_RT) { GAS unsigned char* wsl = (GAS unsigned char*)args.ws; asm volatile("" : "+s"(wsl));
        constexpr int NRT = T / 256;
        const bool split = F.G >= 2 * NRT;
        if (!split || (int)blockIdx.x < NRT) {
            pg8::Gemm g{X1B, WRT, DM, DM, DM, nullptr}; pg8::StaticOrder S; S.init(T, NROUTE, split ? NRT : F.G, (int)blockIdx.x); pg8::EpiF32Rs E{LOGITS, NROUTE, SSQ1};
            pg8::gemm_phase<pg8::EpiF32Rs, pg8::StaticOrder, false>(F.lds, g, S, E);
            __syncthreads();
            pg8::Unit u;
            for (int i = 0; S.next(i, u); ++i) {
                if (F.tid < 256) { const int t = u.pm * 256 + F.tid;
                    const float* lg = LOGITS + (size_t)t * NROUTE; float gl[8]; int gi = 0; float gm = -3.4e38f;
#pragma unroll
                    for (int j = 0; j < 8; ++j) { gl[j] = lg[j] + args.in[I_BGRP][j]; if (gl[j] > gm) { gm = gl[j]; gi = j; } }
                    float gs = 0.f;
#pragma unroll
                    for (int j = 0; j < 8; ++j) gs += __expf(gl[j] - gm);
                    const float pg = 1.f / gs;
                    float el[8]; int i0 = 0; float m0 = -3.4e38f;
#pragma unroll
                    for (int j = 0; j < 8; ++j) { el[j] = lg[8 + gi * 8 + j] + args.in[I_BEXP][gi * 8 + j]; if (el[j] > m0) { m0 = el[j]; i0 = j; } }
                    int i1 = 0; float m1 = -3.4e38f;
#pragma unroll
                    for (int j = 0; j < 8; ++j) if (j != i0 && el[j] > m1) { m1 = el[j]; i1 = j; }
                    const float x1 = __expf(m1 - m0), w0 = pg / (1.f + x1), w1 = pg * x1 / (1.f + x1);
                    const int e0 = gi * 8 + i0, e1 = gi * 8 + i1;
                    const unsigned p0 = __hip_atomic_fetch_add(CNT + e0, 1u, RLX_AGENT), p1 = __hip_atomic_fetch_add(CNT + e1, 1u, RLX_AGENT);
                    TOKE[2 * t] = e0; TOKE[2 * t + 1] = e1; TOKP[2 * t] = (int)p0; TOKP[2 * t + 1] = (int)p1; TOKW[2 * t] = w0; TOKW[2 * t + 1] = w1; }
            }
        }
        if (!split || (int)blockIdx.x >= NRT) {
            pg8::Gemm g{PB, WPP, PLE, PLE, PLE, nullptr}; pg8::StaticOrder S; S.init(T, DM, split ? F.G - NRT : F.G, split ? (int)blockIdx.x - NRT : (int)blockIdx.x); pg8::EpiBf16Ssq E{PLEB, DM, SSQP};
            pg8::gemm_phase<pg8::EpiBf16Ssq, pg8::StaticOrder, false>(F.lds, g, S, E);
            if (split) {
                __syncthreads();
                int lane_c = F.tid & 63; asm volatile("" : "+v"(lane_c)); LAS unsigned* scr64 = (LAS unsigned*)scr;
                expert_conv_stream(CONV_RT + ((int)blockIdx.x - NRT) * NWAVES + F.wave, NE * 768, (F.G - NRT) * NWAVES, args.in[I_WEG], args.in[I_WEU], args.in[I_WED], wsl, scr64, lane_c, args.in[I_GFFN]);
                __syncthreads(); }
        }
    }
    SEAM(PH_RT);
    LAS int* tstart = (LAS int*)(F.lds + TAB_OFF); LAS int* ulist = tstart + 72;
    if (IN(PH_SCAT) || IN(PH_GU) || IN(PH_DN)) {
        if (F.tid == 0) { int acc = 0; for (int e = 0; e < NE; ++e) { tstart[e] = acc; acc += ((int)__hip_atomic_load(CNT + e, RLX_AGENT) + 255) >> 8; } tstart[NE] = acc; }
        __syncthreads();
    }
    PHASE(PH_SCAT) { GAS unsigned char* wsl = (GAS unsigned char*)args.ws; asm volatile("" : "+s"(wsl));
        for (int t = blockIdx.x * 512 + F.tid; t < T; t += F.G * 512) {
#pragma unroll
            for (int k = 0; k < 2; ++k) { const int e = TOKE[2 * t + k], slot = tstart[e] * 256 + TOKP[2 * t + k]; ROWTOK[slot] = t; TOKP[2 * t + k] = slot; } }
    }
    SEAM(PH_SCAT);
    PHASE(PH_GU) { GAS unsigned char* wsl = (GAS unsigned char*)args.ws; asm volatile("" : "+s"(wsl));
        const int total = tstart[NE] * 4; int n = 0;
        if (F.tid == 0) { for (int L = blockIdx.x; L < total && n < 64; L += F.G, ++n) { const int mt = L >> 2; int e = 0; while (tstart[e + 1] <= mt) ++e; ulist[2 * n] = mt; ulist[2 * n + 1] = e * 4 + (L & 3); } ulist[128] = n; }
        __syncthreads();
        pg8::ListOrder S{ulist, ulist[128], (const char*)(wsl + WS_WGU_A), (const char*)(wsl + WS_WGU_B), WGU_SPLIT, 4, (size_t)(4 * MiB)}; pg8::Gemm g{X1B, nullptr, DM, DM, DM, ROWTOK}; pg8::EpiSwiGLU E{ACT, ROWTOK, SSQ1};
        pg8::gemm_phase<pg8::EpiSwiGLU, pg8::ListOrder, true>(F.lds, g, S, E);
        __syncthreads();
    }
    SEAM(PH_GU);
    PHASE(PH_DN) { GAS unsigned char* wsl = (GAS unsigned char*)args.ws; asm volatile("" : "+s"(wsl));
        const int total = tstart[NE] * 8; int n = 0;
        if (F.tid == 0) { for (int L = blockIdx.x; L < total && n < 64; L += F.G, ++n) { const int mt = L >> 3; int e = 0; while (tstart[e + 1] <= mt) ++e; ulist[2 * n] = mt; ulist[2 * n + 1] = e * 8 + (L & 7); } ulist[128] = n; }
        __syncthreads();
        pg8::ListOrder S{ulist, ulist[128], (const char*)(wsl + WS_WD), (const char*)(wsl + WS_WD), NE, 8, (size_t)(2 * MiB)}; pg8::Gemm g{ACT, nullptr, DE, DE, DE, nullptr}; pg8::EpiDown E{YB};
        pg8::gemm_phase<pg8::EpiDown, pg8::ListOrder, false>(F.lds, g, S, E);
        __syncthreads();
    }
    SEAM(PH_DN);
    PHASE(PH_E4) { GAS unsigned char* wsl = (GAS unsigned char*)args.ws; asm volatile("" : "+s"(wsl)); int lane_l = F.tid & 63; asm volatile("" : "+v"(lane_l)); const int lane = lane_l;
        int s0n = 0, s1n = 0; float w0n = 0.f, w1n = 0.f;
        if (gw < T) { s0n = TOKP[2 * gw]; s1n = TOKP[2 * gw + 1]; w0n = TOKW[2 * gw]; w1n = TOKW[2 * gw + 1]; }
        for (int t = gw; t < T; t += NGW) {
            const int s0 = s0n, s1 = s1n; const float w0 = w0n, w1 = w1n;
            const u32x2* xr = (const u32x2*)(X1B + (size_t)t * DM) + lane; u32x2* xo = (u32x2*)(X2B + (size_t)t * DM) + lane; const u32x2* y0 = (const u32x2*)(YB + (size_t)s0 * DM) + lane; const u32x2* y1 = (const u32x2*)(YB + (size_t)s1 * DM) + lane;
            f32x4 v[8]; u32x2 ya[8], yb[8];
#pragma unroll
            for (int j = 0; j < 8; ++j) { const u32x2 xw = xr[64 * j]; v[j] = (f32x4){bflo(xw.x), bfhi(xw.x), bflo(xw.y), bfhi(xw.y)}; ya[j] = y0[64 * j]; yb[j] = y1[64 * j]; }
            if (t + NGW < T) { const int tn = t + NGW; s0n = TOKP[2 * tn]; s1n = TOKP[2 * tn + 1]; w0n = TOKW[2 * tn]; w1n = TOKW[2 * tn + 1]; }
            float s = 0.f;
#pragma unroll
            for (int j = 0; j < 8; ++j) { const u32x2 a = ya[j], b = yb[j];
                v[j].x += w0 * bflo(a.x) + w1 * bflo(b.x); v[j].y += w0 * bfhi(a.x) + w1 * bfhi(b.x); v[j].z += w0 * bflo(a.y) + w1 * bflo(b.y); v[j].w += w0 * bfhi(a.y) + w1 * bfhi(b.y);
                s += (v[j].x * v[j].x + v[j].y * v[j].y) + (v[j].z * v[j].z + v[j].w * v[j].w); }
#pragma unroll
            for (int o = 1; o < 64; o <<= 1) s += __shfl_xor(s, o);
#pragma unroll
            for (int j = 0; j < 8; ++j) { u32x2 xw; xw.x = cvtpk(v[j].x, v[j].y); xw.y = cvtpk(v[j].z, v[j].w); xo[64 * j] = xw; }
            if (lane == 0) RSTD2[t] = rsqrtf(s * (1.f / DM) + EPS);
        }
    }
    SEAM(PH_E4);
    PHASE(PH_PLE) { GAS unsigned char* wsl = (GAS unsigned char*)args.ws; asm volatile("" : "+s"(wsl));
        pg8::Gemm g{X2B, WPG, DM, DM, DM, nullptr}; pg8::StaticOrder S; S.init(T, DM, F.G, (int)blockIdx.x); pg8::EpiPle E{OUT, X2B, PLEB, SSQP, RSTD2, args.in[I_GPP]};
        pg8::gemm_phase<pg8::EpiPle, pg8::StaticOrder, false>(F.lds, g, S, E);
    }
#undef IN
#undef SEAM
}

#undef WIN
#undef WQB
#undef WKVB
#undef W2T
#undef A2T
#undef G2T
#undef WBR
#undef WOUT
#undef WRT
#undef WPG
#undef WPP
#undef HB
#undef PB
#undef TAB
#undef PROJ
#undef QB_
#undef KVB
#undef K2B
#undef OA
#undef OB
#undef LW
#undef AA
#undef GG
#undef TW
#undef ZA
#undef SG
#undef MERGED
#undef YR
#undef WGU_E
#undef WD_E
#undef RSTD2
#undef ACT
#undef YB
#undef LOGITS
#undef PLEB
#undef RSTDQ
#undef RSTDKV
#undef RSTDPLE
#undef TOKE
#undef TOKP
#undef TOKW
#undef ROWTOK
#undef X1B
#undef X2B
#undef CNT
#undef PGF
#undef LGF
#undef GSF
#undef PRM
#undef VM
#undef PT
#undef LL
#undef QQ
#undef SC
extern "C" void kernel_launch(void* const* d_in, const int* in_sizes, int n_in, void* d_out, int out_size, void* d_ws, size_t ws_size, hipStream_t stream) {
    static int grid = 0;
    if (grid == 0) {
        if (n_in != 36 || in_sizes[0] != T * DM || out_size != T * DM || ws_size < WS_END) { fprintf(stderr, "kernel_launch: shape mismatch n_in %d in0 %d out %d ws %zu (need %zu)\n", n_in, n_in > 0 ? in_sizes[0] : -1, out_size, ws_size, (size_t)WS_END); grid = -1; return; }
        int dev = 0, cus = 0, per_cu = 0;
        if (hipGetDevice(&dev) != hipSuccess || hipDeviceGetAttribute(&cus, hipDeviceAttributeMultiprocessorCount, dev) != hipSuccess) { grid = -1; return; }
        if (hipFuncSetAttribute((const void*)mega, hipFuncAttributeMaxDynamicSharedMemorySize, LDS_BYTES) != hipSuccess) { fprintf(stderr, "kernel_launch: hipFuncSetAttribute failed\n"); grid = -1; return; }
        if (hipOccupancyMaxActiveBlocksPerMultiprocessor(&per_cu, (const void*)mega, NWAVES * 64, LDS_BYTES) != hipSuccess || per_cu < 1) fprintf(stderr, "kernel_launch: occupancy query says %d\n", per_cu);
        (void)hipGetLastError();
        grid = cus;
    }
    if (grid < 0) return;
    (void)hipMemsetAsync((char*)d_ws + WS_CTL, 0, CTL_ZERO_BYTES, stream);
    Args a{};
    for (int i = 0; i < 36; ++i) a.in[i] = (const float*)d_in[i];
    a.out = (float*)d_out; a.ws = (unsigned char*)d_ws;
    for (int i = 0; i < 32; ++i) a.inv_freq[i] = (float)(1.0 / pow(10000.0, (double)(2 * i) / 64.0));
#if MK_ONE_LAUNCH
    if (PROBE_PH < 0) { a.ph_lo = 0; a.ph_hi = N_PHASES; a.li = 0; hipLaunchKernelGGL(mega, dim3(grid), dim3(NWAVES * 64), LDS_BYTES, stream, a); }
    else {
        for (int r = 1; r < PROBE_N; ++r) { a.ph_lo = PROBE_PH; a.ph_hi = PROBE_PH + 1; a.li = 1; hipLaunchKernelGGL(mega, dim3(grid), dim3(NWAVES * 64), LDS_BYTES, stream, a); }
        a.ph_lo = 0; a.ph_hi = N_PHASES; a.li = 0; hipLaunchKernelGGL(mega, dim3(grid), dim3(NWAVES * 64), LDS_BYTES, stream, a);
    }
#else
    for (int p = 0; p < N_PHASES; ++p) { a.ph_lo = p; a.ph_hi = p + 1; a.li = 0; hipLaunchKernelGGL(mega, dim3(grid), dim3(NWAVES * 64), LDS_BYTES, stream, a); }
#endif
}
```
